# Optimizing an MI355X kernel written in HIP

```python
import jax, jax.numpy as jnp
from jax import lax
import numpy as np

D_MODEL = 2048
BATCH = 4
SEQ = 8192
DEPTH = 4

HEAD_DIM = 128
N_MIX_HEADS = D_MODEL // HEAD_DIM
N_ATTN_HEADS = 3 * N_MIX_HEADS // 4
N_SGU_GROUPS = N_MIX_HEADS - N_ATTN_HEADS
SGU_GROUP = HEAD_DIM
ATTN_WIDTH = N_ATTN_HEADS * HEAD_DIM
SGU_WIDTH = N_SGU_GROUPS * SGU_GROUP
MIX_IN = 3 * ATTN_WIDTH + 2 * SGU_WIDTH
CHUNK = 128
DILATED_BRANCHES = ((128, 1), (512, 4), (2048, 16))
BRANCH_BLOCK = 128
ROPE_THETA = 500000.0
ROPE_DIM = HEAD_DIM // 4
CONV_WIDTH = 3
D_FF = -(-8 * D_MODEL // (3 * 256)) * 256
N_EVEN = (DEPTH + 1) // 2
N_ODD = DEPTH // 2
EPS = 1e-6

kernel_name = "hybrid_dilated_attn_sgu_shortconv_adaln"


def rmsnorm(x, g):
    xf = x.astype(jnp.float32)
    y = xf * lax.rsqrt(jnp.mean(xf * xf, axis=-1, keepdims=True) + EPS)
    return (y * g.astype(jnp.float32)).astype(x.dtype)


def rope_tables(positions):
    inv_freq = ROPE_THETA ** (-jnp.arange(0, ROPE_DIM, 2, dtype=jnp.float32) / ROPE_DIM)
    ang = positions.astype(jnp.float32)[..., None] * inv_freq
    return jnp.cos(ang)[:, :, None, :], jnp.sin(ang)[:, :, None, :]


def apply_partial_rope(t, cos, sin):
    half = ROPE_DIM // 2
    t1 = t[..., :half].astype(jnp.float32)
    t2 = t[..., half:ROPE_DIM].astype(jnp.float32)
    rot = jnp.concatenate([t1 * cos - t2 * sin, t2 * cos + t1 * sin], axis=-1).astype(t.dtype)
    return jnp.concatenate([rot, t[..., ROPE_DIM:]], axis=-1)


def _dilated_branch(q, k, v, span, dilation):
    b, s, h, d = q.shape
    n = s // dilation
    nb = -(-n // BRANCH_BLOCK)
    pad = nb * BRANCH_BLOCK - n

    def to_sub(t):
        t = t.reshape(b, n, dilation, h, d).transpose(0, 2, 1, 3, 4)
        t = jnp.pad(t, ((0, 0), (0, 0), (0, pad), (0, 0), (0, 0)))
        return t.reshape(b, dilation, nb, BRANCH_BLOCK, h, d)

    def with_prev(t):
        prev = jnp.pad(t, ((0, 0), (0, 0), (1, 0), (0, 0), (0, 0), (0, 0)))[:, :, :nb]
        return jnp.concatenate([prev, t], axis=3)

    qs = to_sub(q)
    kb = with_prev(to_sub(k))
    vb = with_prev(to_sub(v))
    scores = jnp.einsum("brnqhd,brnkhd->brnqhk", qs, kb).astype(jnp.float32) * (d ** -0.5)

    qi = jnp.arange(BRANCH_BLOCK)[:, None]
    kj = jnp.arange(2 * BRANCH_BLOCK)[None, :]
    dist = qi + BRANCH_BLOCK - kj
    band = (dist >= 0) & (dist <= span)
    not_first = jnp.arange(nb)[:, None, None] > 0
    valid = band[None] & (not_first | (kj >= BRANCH_BLOCK)[None])
    scores = jnp.where(valid[None, None, :, :, None, :], scores, -jnp.inf)

    m = jnp.max(scores, axis=-1, keepdims=True)
    p = jnp.exp(scores - m)
    l = jnp.sum(p, axis=-1)
    o = jnp.einsum("brnqhk,brnkhd->brnqhd", p, vb.astype(jnp.float32)) / l[..., None]
    lse = m[..., 0] + jnp.log(l)

    def from_sub(t):
        t = t.reshape(b, dilation, nb * BRANCH_BLOCK, *t.shape[4:])[:, :, :n]
        t = jnp.moveaxis(t, 1, 2)
        return t.reshape(b, s, *t.shape[3:])

    return from_sub(o), from_sub(lse)


def dilated_attention(q, k, v):
    outs, lses = zip(*[_dilated_branch(q, k, v, w // dil, dil) for w, dil in DILATED_BRANCHES])
    alpha = jax.nn.softmax(jnp.stack(lses, axis=-1), axis=-1)
    o = sum(alpha[..., i, None] * outs[i] for i in range(len(outs)))
    return o.astype(q.dtype)


def spatial_gating(u, v, w_s, b_s):
    b, s, _ = u.shape
    shp = (b, s // CHUNK, CHUNK, N_SGU_GROUPS, SGU_GROUP)
    u = jax.nn.gelu(u).reshape(shp)
    v = jax.nn.gelu(v).reshape(shp)
    w = w_s * jnp.tril(jnp.ones((CHUNK, CHUNK), w_s.dtype))
    mixed = jnp.einsum("gts,bnsgc->bntgc", w, v) + b_s.T[:, :, None]
    return (u * mixed).reshape(b, s, SGU_WIDTH)


def attn_sgu_mixer(h, w_in, w_s, b_s, w_out, cos, sin):
    b, s, _ = h.shape
    z = h @ w_in
    q, k, v, u, vg = jnp.split(
        z, [ATTN_WIDTH, 2 * ATTN_WIDTH, 3 * ATTN_WIDTH, 3 * ATTN_WIDTH + SGU_WIDTH], axis=-1)
    hs = (b, s, N_ATTN_HEADS, HEAD_DIM)
    q = apply_partial_rope(q.reshape(hs), cos, sin)
    k = apply_partial_rope(k.reshape(hs), cos, sin)
    attn = dilated_attention(q, k, v.reshape(hs)).reshape(b, s, ATTN_WIDTH)
    sgu = spatial_gating(u, vg, w_s, b_s)
    return jnp.concatenate([attn, sgu], axis=-1) @ w_out


def short_conv_mixer(h, w_in, conv_w, w_out):
    gb, gc, hx = jnp.split(h @ w_in, 3, axis=-1)
    y = gc * hx
    s = y.shape[1]
    y_pad = jnp.pad(y, ((0, 0), (CONV_WIDTH - 1, 0), (0, 0)))
    conv = sum(conv_w[j] * y_pad[:, j:j + s] for j in range(CONV_WIDTH))
    return (gb * conv) @ w_out


def swiglu(h, w_gate, w_up, w_down):
    return (jax.nn.silu(h @ w_gate) * (h @ w_up)) @ w_down


def setup_inputs(seed: int = 0) -> dict:
    key = jax.random.key(seed)
    ks = jax.random.split(key, 20)
    nrm = jax.random.normal
    f32 = jnp.float32
    d = D_MODEL
    x = nrm(ks[0], (BATCH, SEQ, d), f32)
    c = nrm(ks[1], (BATCH, d), f32)
    positions = (jnp.arange(SEQ, dtype=jnp.int32)[None, :]
                 + jax.random.randint(ks[2], (BATCH, 1), 0, 4096, dtype=jnp.int32))
    ada_w = nrm(ks[3], (DEPTH, d, 6 * d), f32) * (0.5 * d ** -0.5)
    ada_b = nrm(ks[4], (DEPTH, 6 * d), f32) * 0.02
    norm_mix = 1.0 + 0.02 * nrm(ks[5], (DEPTH, d), f32)
    norm_ffn = 1.0 + 0.02 * nrm(ks[6], (DEPTH, d), f32)
    ab_w_in = nrm(ks[7], (N_EVEN, d, MIX_IN), f32) * d ** -0.5
    sgu_w = nrm(ks[8], (N_EVEN, N_SGU_GROUPS, CHUNK, CHUNK), f32) * CHUNK ** -0.5
    sgu_b = 1.0 + 0.1 * nrm(ks[9], (N_EVEN, N_SGU_GROUPS, CHUNK), f32)
    ab_w_out = nrm(ks[10], (N_EVEN, ATTN_WIDTH + SGU_WIDTH, d), f32) * (ATTN_WIDTH + SGU_WIDTH) ** -0.5
    conv_w_in = nrm(ks[11], (N_ODD, d, 3 * d), f32) * d ** -0.5
    conv_w = nrm(ks[12], (N_ODD, CONV_WIDTH, d), f32) * CONV_WIDTH ** -0.5
    conv_w_out = nrm(ks[13], (N_ODD, d, d), f32) * d ** -0.5
    ffn_w_gate = nrm(ks[14], (DEPTH, d, D_FF), f32) * d ** -0.5
    ffn_w_up = nrm(ks[15], (DEPTH, d, D_FF), f32) * d ** -0.5
    ffn_w_down = nrm(ks[16], (DEPTH, D_FF, d), f32) * D_FF ** -0.5
    final_norm = 1.0 + 0.02 * nrm(ks[17], (d,), f32)
    return {"x": x, "c": c, "positions": positions, "ada_w": ada_w, "ada_b": ada_b,
            "norm_mix": norm_mix, "norm_ffn": norm_ffn, "ab_w_in": ab_w_in,
            "sgu_w": sgu_w, "sgu_b": sgu_b, "ab_w_out": ab_w_out,
            "conv_w_in": conv_w_in, "conv_w": conv_w, "conv_w_out": conv_w_out,
            "ffn_w_gate": ffn_w_gate, "ffn_w_up": ffn_w_up, "ffn_w_down": ffn_w_down,
            "final_norm": final_norm}


def reference(x, c, positions, ada_w, ada_b, norm_mix, norm_ffn, ab_w_in, sgu_w, sgu_b,
              ab_w_out, conv_w_in, conv_w, conv_w_out, ffn_w_gate, ffn_w_up, ffn_w_down,
              final_norm):
    cos, sin = rope_tables(positions)
    c_act = jax.nn.silu(c)
    for layer in range(DEPTH):
        mod = (c_act @ ada_w[layer] + ada_b[layer])[:, None, :]
        sh_m, sc_m, g_m, sh_f, sc_f, g_f = jnp.split(mod, 6, axis=-1)
        h = rmsnorm(x, norm_mix[layer]) * (1 + sc_m) + sh_m
        i = layer // 2
        if layer % 2 == 0:
            mix = attn_sgu_mixer(h, ab_w_in[i], sgu_w[i], sgu_b[i], ab_w_out[i], cos, sin)
        else:
            mix = short_conv_mixer(h, conv_w_in[i], conv_w[i], conv_w_out[i])
        x = x + g_m * mix
        h = rmsnorm(x, norm_ffn[layer]) * (1 + sc_f) + sh_f
        x = x + g_f * swiglu(h, ffn_w_gate[layer], ffn_w_up[layer], ffn_w_down[layer])
    return rmsnorm(x, final_norm)
```

```cpp
#include <hip/hip_runtime.h>
#include <cstdio>
#include <cstdint>

#ifndef PROBE_REPS
#define PROBE_REPS 0
#define PROBE_LO 0
#define PROBE_HI 0
#define PROBE_DRY 0
#endif
#ifndef MK_PER_PHASE
#define MK_PER_PHASE 0
#endif

constexpr int BATCH = 4, SEQ = 8192, DM = 2048, MTOK = BATCH * SEQ, DFF = 5632, HD = 128, NAH = 12, AW = 1536, SW = 512, MIXIN = 5632, CIN = 6144, NGU = 2 * DFF;
constexpr int ZP = 5632;
constexpr float EPS = 1e-6f;

typedef unsigned short bf16;
typedef short bf16x8 __attribute__((ext_vector_type(8)));
typedef short s16x4 __attribute__((ext_vector_type(4)));
typedef float f32x4 __attribute__((ext_vector_type(4)));
typedef float f32x16 __attribute__((ext_vector_type(16)));
typedef float f32x2 __attribute__((ext_vector_type(2)));
typedef unsigned u32x4 __attribute__((ext_vector_type(4)));
typedef unsigned u32x2 __attribute__((ext_vector_type(2)));
#define LAS __attribute__((address_space(3)))
#define GAS __attribute__((address_space(1)))

__device__ __forceinline__ unsigned cvt_pk_bf16(float lo, float hi) { unsigned r; asm volatile("v_cvt_pk_bf16_f32 %0, %1, %2" : "=v"(r) : "v"(lo), "v"(hi)); return r; }
__device__ __forceinline__ float bf_lo(unsigned w) { return __uint_as_float(w << 16); }
__device__ __forceinline__ float bf_hi(unsigned w) { return __uint_as_float(w & 0xffff0000u); }
__device__ __forceinline__ float fast_exp(float x) { return __builtin_amdgcn_exp2f(x * 1.4426950408889634f); }
__device__ __forceinline__ float gelu_tanh(float x) {
    const float t = x * (1.0f + 0.044715f * x * x) * (-2.0f * 0.7978845608028654f * 1.4426950408889634f);
    return x * __builtin_amdgcn_rcpf(1.0f + __builtin_amdgcn_exp2f(t));
}
__device__ __forceinline__ float silu_f(float x) { return x * __builtin_amdgcn_rcpf(1.0f + __builtin_amdgcn_exp2f(x * -1.4426950408889634f)); }

template <int O> __device__ __forceinline__ float swz_xor(float v) { return __int_as_float(__builtin_amdgcn_ds_swizzle(__float_as_int(v), (O << 10) | 0x1f)); }
__device__ __forceinline__ float xor1(float v) { return __int_as_float(__builtin_amdgcn_update_dpp(0, __float_as_int(v), 0xB1, 0xf, 0xf, true)); }
__device__ __forceinline__ float half_sum(float v) { auto rr = __builtin_amdgcn_permlane32_swap(__float_as_uint(v), __float_as_uint(v), false, false); return __uint_as_float(rr[0]) + __uint_as_float(rr[1]); }
typedef unsigned u64; typedef int i64;
constexpr float SSQ_SCALE = 1024.0f, BIAS_SCALE = 1048576.0f;
struct NormIn { const u64* ssq; const i64* bias; int N; LAS unsigned char* stg;
    __device__ __forceinline__ void stage(int pm, int pn, int lane) const {
        __builtin_amdgcn_global_load_lds((const unsigned*)(ssq + (size_t)pm * 256 + lane * 4), (LAS unsigned*)stg, 16, 0, 0);
        __builtin_amdgcn_global_load_lds((const unsigned*)(bias + (size_t)(pm >> 5) * N + pn * 256 + lane * 4), (LAS unsigned*)(stg + 1024), 16, 0, 0); }
    __device__ __forceinline__ float rs(int rowl) const;
    __device__ __forceinline__ f32x4 bias4l(int coll) const;
};
__device__ __forceinline__ float rs_of(const u64* ssq, int row) { return __builtin_amdgcn_rsqf((float)ssq[row] * (1.0f / (SSQ_SCALE * DM)) + EPS); }
typedef int i32x4 __attribute__((ext_vector_type(4)));
__device__ __forceinline__ f32x4 bias4(const i64* p) { const i32x4 v = *(const i32x4*)p; return (f32x4){(float)v.x, (float)v.y, (float)v.z, (float)v.w} * (1.0f / BIAS_SCALE); }
__device__ __forceinline__ float NormIn::rs(int rowl) const { return __builtin_amdgcn_rsqf((float)((const LAS u64*)stg)[rowl] * (1.0f / (SSQ_SCALE * DM)) + EPS); }
__device__ __forceinline__ f32x4 NormIn::bias4l(int coll) const { const i32x4 v = *(const LAS i32x4*)(stg + 1024 + coll * 4); return (f32x4){(float)v.x, (float)v.y, (float)v.z, (float)v.w} * (1.0f / BIAS_SCALE); }
__device__ __forceinline__ void ssq_add(u64* p, float v) { __hip_atomic_fetch_add(p, (u64)(v * SSQ_SCALE + 0.5f), __ATOMIC_RELAXED, __HIP_MEMORY_SCOPE_AGENT); }

namespace pg8 {
constexpr int BM = 256, BK = 64, HALF = 128, HTB = HALF * BK * 2, STAGE_BYTES = 8 * HTB, NXCD = 8, WGM = 4;
__host__ __device__ __forceinline__ int lds_byte(int r, int c) { const int st = (r >> 4) * 2 + (c >> 5), rr = r & 15, cc = c & 31, ob = rr * 64 + cc * 2; return st * 1024 + (ob ^ (((ob >> 9) & 1) << 5)); }
__host__ __device__ __forceinline__ void stage_rc(int b, int& R, int& C) { const int st = b / 1024, sb = b % 1024, swz = sb ^ (((sb >> 9) & 1) << 5); R = (st >> 1) * 16 + swz / 64; C = (st & 1) * 32 + (swz % 64) / 2; }
__host__ __device__ __forceinline__ int perm32(int rho) { const int n = rho >> 4, i = rho & 15; return 8 * (i >> 2) + 4 * n + (i & 3); }

struct Unit { int pm, pn; };
struct Gemm { const bf16* A; const bf16* Bt; int M, N, K; };

struct StaticOrder {
    int nM, nN, nwg, G, c;
    __host__ __device__ void init(int M, int N, int G_, int c_) { nM = M / BM; nN = N / BM; nwg = nM * nN; G = G_; c = c_; }
    __host__ __device__ bool next(int i, Unit& u) const {
        const long L = (long)i * G + c; if (L >= nwg) return false;
        int wgid = (int)L; { const int q = nwg / NXCD, r = nwg % NXCD, xcd = wgid % NXCD, off = wgid / NXCD; wgid = (xcd < r ? xcd * (q + 1) : r * (q + 1) + (xcd - r) * q) + off; }
        const int nig = WGM * nN, gid = wgid / nig, fm = gid * WGM, gsz = (nM - fm) < WGM ? (nM - fm) : WGM;
        u.pm = fm + ((wgid % nig) % gsz); u.pn = (wgid % nig) / gsz; return true;
    }
    __device__ __forceinline__ void a_ready(const Unit&) const {}
    __device__ __forceinline__ void done(const Unit&) const {}
};

__device__ __forceinline__ void store8(bf16* p, f32x4 v0, f32x4 v1) {
    u32x4 w; w.x = cvt_pk_bf16(v0[0], v0[1]); w.y = cvt_pk_bf16(v0[2], v0[3]); w.z = cvt_pk_bf16(v1[0], v1[1]); w.w = cvt_pk_bf16(v1[2], v1[3]);
    *(u32x4*)p = w;
}

struct EpiInE {
    bf16* Z; const float* RT; NormIn nb;
    __device__ __forceinline__ void stage(const Unit& u, int lane) const { nb.stage(u.pm, u.pn, lane); }
    __device__ __forceinline__ void operator()(const f32x4 (&acc)[2][2][4][2], const Unit& u, int wr, int wc, int fr, int fq) const {
        const int row0 = u.pm * BM + wr * 64 + fr, col0 = u.pn * BM + wc * 32 + 8 * fq;
        f32x4 bv[2][2];
        { const int bp = wc * 32 + 4 * fq;
#pragma unroll
          for (int bj = 0; bj < 2; ++bj)
#pragma unroll
              for (int n = 0; n < 2; ++n) bv[bj][n] = nb.bias4l(bp + bj * HALF + n * 16); }
        if (u.pn < 12) {
            const bool rot = (wc == 0);
#pragma unroll
            for (int ai = 0; ai < 2; ++ai) {
                f32x4 csq[4], snq[4];
#pragma unroll
                for (int m = 0; m < 4; ++m) { csq[m] = (f32x4){1.f, 1.f, 1.f, 1.f}; snq[m] = (f32x4){0.f, 0.f, 0.f, 0.f}; }
                if (rot) {
#pragma unroll
                    for (int m = 0; m < 4; ++m) { const int row = row0 + ai * HALF + m * 16; csq[m] = *(const f32x4*)(RT + (size_t)row * 32 + 4 * fq); snq[m] = *(const f32x4*)(RT + (size_t)row * 32 + 16 + 4 * fq); } }
#pragma unroll
                for (int m = 0; m < 4; ++m) { const int row = row0 + ai * HALF + m * 16; bf16* rowp = Z + (size_t)row * ZP + col0; const float rs = nb.rs(row - u.pm * BM);
                    const f32x4 cs = csq[m], sn = snq[m];
#pragma unroll
                    for (int bj = 0; bj < 2; ++bj) { const f32x4 t1 = acc[ai][bj][m][0] * rs + bv[bj][0], t2 = acc[ai][bj][m][1] * rs + bv[bj][1];
                        store8(rowp + bj * HALF, t1 * cs - t2 * sn, t2 * cs + t1 * sn); } } }
        } else if (u.pn < 18) {
#pragma unroll
            for (int ai = 0; ai < 2; ++ai)
#pragma unroll
                for (int m = 0; m < 4; ++m) { const int row = row0 + ai * HALF + m * 16; bf16* rowp = Z + (size_t)row * ZP + col0; const float rs = nb.rs(row - u.pm * BM);
#pragma unroll
                    for (int bj = 0; bj < 2; ++bj) store8(rowp + bj * HALF, acc[ai][bj][m][0] * rs + bv[bj][0], acc[ai][bj][m][1] * rs + bv[bj][1]); }
        } else {
#pragma unroll
            for (int ai = 0; ai < 2; ++ai)
#pragma unroll
                for (int m = 0; m < 4; ++m) { const int row = row0 + ai * HALF + m * 16; bf16* rowp = Z + (size_t)row * ZP + col0; const float rs = nb.rs(row - u.pm * BM);
#pragma unroll
                    for (int bj = 0; bj < 2; ++bj) { f32x4 v0 = acc[ai][bj][m][0] * rs + bv[bj][0], v1 = acc[ai][bj][m][1] * rs + bv[bj][1];
#pragma unroll
                        for (int j = 0; j < 4; ++j) { v0[j] = gelu_tanh(v0[j]); v1[j] = gelu_tanh(v1[j]); }
                        store8(rowp + bj * HALF, v0, v1); } }
        }
    }
};
struct EpiInO {
    bf16* GB; bf16* Y; NormIn nb;
    __device__ __forceinline__ void stage(const Unit& u, int lane) const { nb.stage(u.pm, u.pn, lane); }
    __device__ __forceinline__ void operator()(const f32x4 (&acc)[2][2][4][2], const Unit& u, int wr, int wc, int fr, int fq) const {
        const int row0 = u.pm * BM + wr * 64 + fr;
        f32x4 bv[2][2];
        { const int bp = wc * 32 + 4 * fq;
#pragma unroll
          for (int bj = 0; bj < 2; ++bj)
#pragma unroll
              for (int n = 0; n < 2; ++n) bv[bj][n] = nb.bias4l(bp + bj * HALF + n * 16); }
        if (u.pn < 8) { const int col0 = u.pn * BM + wc * 32 + 8 * fq;
#pragma unroll
            for (int ai = 0; ai < 2; ++ai)
#pragma unroll
                for (int m = 0; m < 4; ++m) { const int row = row0 + ai * HALF + m * 16; bf16* rowp = GB + (size_t)row * DM + col0; const float rs = nb.rs(row - u.pm * BM);
#pragma unroll
                    for (int bj = 0; bj < 2; ++bj) store8(rowp + bj * HALF, acc[ai][bj][m][0] * rs + bv[bj][0], acc[ai][bj][m][1] * rs + bv[bj][1]); }
        } else { const int col0 = (u.pn - 8) * HALF + wc * 32 + 8 * fq;
#pragma unroll
            for (int ai = 0; ai < 2; ++ai)
#pragma unroll
                for (int m = 0; m < 4; ++m) { const int row = row0 + ai * HALF + m * 16; const float rs = nb.rs(row - u.pm * BM);
                    store8(Y + (size_t)row * DM + col0, (acc[ai][0][m][0] * rs + bv[0][0]) * (acc[ai][1][m][0] * rs + bv[1][0]), (acc[ai][0][m][1] * rs + bv[0][1]) * (acc[ai][1][m][1] * rs + bv[1][1])); }
        }
    }
};
struct EpiGU {
    bf16* Hd; NormIn nb;
    __device__ __forceinline__ void stage(const Unit& u, int lane) const { nb.stage(u.pm, u.pn, lane); }
    __device__ __forceinline__ void operator()(const f32x4 (&acc)[2][2][4][2], const Unit& u, int wr, int wc, int fr, int fq) const {
        const int row0 = u.pm * BM + wr * 64 + fr, col0 = u.pn * HALF + wc * 32 + 8 * fq;
        f32x4 bv[2][2];
        { const int bp = wc * 32 + 4 * fq;
#pragma unroll
          for (int bj = 0; bj < 2; ++bj)
#pragma unroll
              for (int n = 0; n < 2; ++n) bv[bj][n] = nb.bias4l(bp + bj * HALF + n * 16); }
#pragma unroll
        for (int ai = 0; ai < 2; ++ai)
#pragma unroll
            for (int m = 0; m < 4; ++m) { const int row = row0 + ai * HALF + m * 16; const float rs = nb.rs(row - u.pm * BM); f32x4 v0, v1;
                const f32x4 g0 = acc[ai][0][m][0] * rs + bv[0][0], g1 = acc[ai][0][m][1] * rs + bv[0][1], u0 = acc[ai][1][m][0] * rs + bv[1][0], u1 = acc[ai][1][m][1] * rs + bv[1][1];
#pragma unroll
                for (int j = 0; j < 4; ++j) { v0[j] = silu_f(g0[j]) * u0[j]; v1[j] = silu_f(g1[j]) * u1[j]; }
                store8(Hd + (size_t)row * ZP + col0, v0, v1); }
    }
};
struct EpiRes {
    const bf16* xin; bf16* xout; const float* gate; int gstride; bf16* Hn; const float* an; int astride; u64* ssq; LAS unsigned char* stg;
    __device__ __forceinline__ void stage(const Unit& u, int lane) const {
        __builtin_amdgcn_global_load_lds((const unsigned*)(gate + (size_t)(u.pm >> 5) * gstride + u.pn * BM + lane * 4), (LAS unsigned*)stg, 16, 0, 0);
        __builtin_amdgcn_global_load_lds((const unsigned*)((Hn ? an : gate) + (size_t)(u.pm >> 5) * astride + u.pn * BM + lane * 4), (LAS unsigned*)(stg + 1024), 16, 0, 0); }
    __device__ __forceinline__ void operator()(const f32x4 (&acc)[2][2][4][2], const Unit& u, int wr, int wc, int fr, int fq) const {
        const int row0 = u.pm * BM + wr * 64 + fr, col0 = u.pn * BM + wc * 32 + 8 * fq;
        const LAS unsigned char* gl = stg + (wc * 32 + 8 * fq) * 4;
        u32x4 xq[2][4][2];
#pragma unroll
        for (int ai = 0; ai < 2; ++ai)
#pragma unroll
            for (int m = 0; m < 4; ++m)
#pragma unroll
                for (int bj = 0; bj < 2; ++bj) xq[ai][m][bj] = *(const u32x4*)(xin + (size_t)(row0 + ai * HALF + m * 16) * DM + col0 + bj * HALF);
#pragma unroll
        for (int ai = 0; ai < 2; ++ai) {
#pragma unroll
            for (int m = 0; m < 4; ++m) { const int row = row0 + ai * HALF + m * 16; const size_t off = (size_t)row * DM + col0; float ps = 0.f;
#pragma unroll
                for (int bj = 0; bj < 2; ++bj) { const u32x4 xi = xq[ai][m][bj];
                    const f32x4 g0 = *(const LAS f32x4*)(gl + bj * HALF * 4), g1 = *(const LAS f32x4*)(gl + bj * HALF * 4 + 16);
                    const f32x4 x0 = (f32x4){bf_lo(xi.x), bf_hi(xi.x), bf_lo(xi.y), bf_hi(xi.y)} + g0 * acc[ai][bj][m][0];
                    const f32x4 x1 = (f32x4){bf_lo(xi.z), bf_hi(xi.z), bf_lo(xi.w), bf_hi(xi.w)} + g1 * acc[ai][bj][m][1];
                    u32x4 w; w.x = cvt_pk_bf16(x0[0], x0[1]); w.y = cvt_pk_bf16(x0[2], x0[3]); w.z = cvt_pk_bf16(x1[0], x1[1]); w.w = cvt_pk_bf16(x1[2], x1[3]);
                    *(u32x4*)(xout + off + bj * HALF) = w;
                    const f32x4 r0 = (f32x4){bf_lo(w.x), bf_hi(w.x), bf_lo(w.y), bf_hi(w.y)}, r1 = (f32x4){bf_lo(w.z), bf_hi(w.z), bf_lo(w.w), bf_hi(w.w)};
                    ps += ((r0[0] * r0[0] + r0[1] * r0[1]) + (r0[2] * r0[2] + r0[3] * r0[3])) + ((r1[0] * r1[0] + r1[1] * r1[1]) + (r1[2] * r1[2] + r1[3] * r1[3]));
                    if (Hn) { const f32x4 a0 = *(const LAS f32x4*)(gl + 1024 + bj * HALF * 4), a1 = *(const LAS f32x4*)(gl + 1024 + bj * HALF * 4 + 16); store8(Hn + off + bj * HALF, r0 * a0, r1 * a1); } }
                ps += swz_xor<16>(ps); ps = half_sum(ps); if (fq == 0) ssq_add(ssq + row, ps);
                asm volatile("" ::: "memory"); } }
    }
};

template <class Epi, class Sched, bool ALIGN_EPI = false, bool SP2 = false>
__device__ __forceinline__ void gemm_phase(LAS unsigned char* lds, const Gemm g, const Sched& S, const Epi& E, const int tid) {
    const int wid = __builtin_amdgcn_readfirstlane(tid >> 6), lane = tid & 63, wr = wid >> 2, wc = wid & 3, fr = lane & 15, fq = lane >> 4;
    const int K = g.K, nt = K / BK;
    unsigned voffA[2];
#pragma unroll
    for (int i = 0; i < 2; ++i) { int R, C; stage_rc(tid * 16 + i * 8192, R, C); voffA[i] = (unsigned)(R * K + C) * 2u; }
#define voffB voffA
    const size_t kstep = (size_t)(BK * 2);
    const size_t hstep = (size_t)HALF * K * 2;
    const size_t tstep = 2 * hstep;
    const unsigned ldsw = (unsigned)wid * 1024u;
    const int aoff = lds_byte(wr * 64 + fr, fq * 8), boff = lds_byte(wc * 32 + fr, fq * 8);
#define PG8_SA(b, h) (((b) * 2 + (h)) * HTB)
#define PG8_SB(b, h) ((4 + (b) * 2 + (h)) * HTB)
#define PG8_STAGE(bufoff, gbase, voff) do { _Pragma("unroll") for (int _i = 0; _i < 2; ++_i) \
        __builtin_amdgcn_global_load_lds((const unsigned*)((const char*)(gbase) + (voff)[_i]), (LAS unsigned*)(lds + (bufoff) + ldsw + _i * 8192), 16, 0, 0); } while (0)
#define PG8_LDA(dst, b, h) do { _Pragma("unroll") for (int m = 0; m < 4; ++m) _Pragma("unroll") for (int k = 0; k < 2; ++k) dst[m][k] = *(const LAS bf16x8*)(lds + PG8_SA(b, h) + aoff + m * 2048 + k * 1024); } while (0)
#define PG8_LDB(dst, b, h) do { _Pragma("unroll") for (int n = 0; n < 2; ++n) _Pragma("unroll") for (int k = 0; k < 2; ++k) dst[n][k] = *(const LAS bf16x8*)(lds + PG8_SB(b, h) + boff + n * 2048 + k * 1024); } while (0)
#define PG8_MMA(ai, bj, At, Bt) do { __builtin_amdgcn_s_setprio(1); _Pragma("unroll") for (int m = 0; m < 4; ++m) _Pragma("unroll") for (int n = 0; n < 2; ++n) _Pragma("unroll") for (int k = 0; k < 2; ++k) \
        acc[ai][bj][m][n] = __builtin_amdgcn_mfma_f32_16x16x32_bf16(Bt[n][k], At[m][k], acc[ai][bj][m][n], 0, 0, 0); __builtin_amdgcn_s_setprio(0); } while (0)
#define PG8_WAIT_V(n) asm volatile("s_waitcnt vmcnt(" #n ")" ::: "memory")
#define PG8_WAIT_L(n) asm volatile("s_waitcnt lgkmcnt(" #n ")" ::: "memory")
#define PG8_BAR __builtin_amdgcn_s_barrier()
#define PG8_SCHED __builtin_amdgcn_sched_barrier(0)
    Unit cur, nxt; int ui = 0;
    if (!S.next(0, cur)) return;
    f32x4 acc[2][2][4][2];
#pragma unroll
    for (int a = 0; a < 2; ++a)
#pragma unroll
        for (int b = 0; b < 2; ++b)
#pragma unroll
            for (int m = 0; m < 4; ++m)
#pragma unroll
                for (int n = 0; n < 2; ++n) acc[a][b][m][n] = (f32x4){0.f, 0.f, 0.f, 0.f};
    bf16x8 At[4][2], B0[2][2], B1[2][2];
    const char* cA = (const char*)g.A + (size_t)cur.pm * tstep; const char* cB = (const char*)g.Bt + (size_t)cur.pn * tstep;
    S.a_ready(cur);
    if constexpr (SP2) {
        PG8_STAGE(PG8_SB(0, 0), cB, voffB); PG8_STAGE(PG8_SB(0, 1), cB + hstep, voffB); PG8_STAGE(PG8_SA(0, 0), cA, voffA); PG8_STAGE(PG8_SA(0, 1), cA + hstep, voffA);
        if (wr == 1) PG8_BAR;
        PG8_WAIT_V(2); PG8_BAR;
        PG8_STAGE(PG8_SB(1, 0), cB + kstep, voffB); PG8_STAGE(PG8_SA(1, 0), cA + kstep, voffA); PG8_STAGE(PG8_SB(1, 1), cB + hstep + kstep, voffB);
        PG8_WAIT_V(6); PG8_BAR;
    } else {
        PG8_STAGE(PG8_SB(0, 0), cB, voffB); PG8_STAGE(PG8_SA(0, 0), cA, voffA); PG8_STAGE(PG8_SB(0, 1), cB + hstep, voffB); PG8_STAGE(PG8_SA(0, 1), cA + hstep, voffA);
        if (wr == 1) PG8_BAR;
        PG8_WAIT_V(4); PG8_BAR;
        PG8_STAGE(PG8_SB(1, 0), cB + kstep, voffB); PG8_STAGE(PG8_SA(1, 0), cA + kstep, voffA); PG8_STAGE(PG8_SB(1, 1), cB + hstep + kstep, voffB);
        PG8_WAIT_V(6); PG8_BAR;
    }
    for (;;) {
        const bool has_next = S.next(ui + 1, nxt);
        const char* nA = has_next ? (const char*)g.A + (size_t)nxt.pm * tstep : cA; const char* nB = has_next ? (const char*)g.Bt + (size_t)nxt.pn * tstep : cB;
        for (int t = 0; t < nt; t += 2) {
            const bool last = (t == nt - 2);
            const char* a1 = cA + (size_t)(t + 1) * kstep;
            const char* a2 = last ? nA : cA + (size_t)(t + 2) * kstep; const char* b2 = last ? nB : cB + (size_t)(t + 2) * kstep;
            const char* a3 = a2 + kstep; const char* b3 = b2 + kstep;
            if (last && has_next) S.a_ready(nxt);
            if (last && wid == 0) E.stage(cur, lane);
            if constexpr (SP2) {
            PG8_LDB(B0, 0, 0); PG8_LDB(B1, 0, 1); PG8_SCHED; PG8_LDA(At, 0, 0); PG8_STAGE(PG8_SA(1, 1), a1 + hstep, voffA);
            PG8_WAIT_V(8); PG8_WAIT_L(0); PG8_BAR; PG8_MMA(0, 0, At, B0); PG8_MMA(0, 1, At, B1); PG8_BAR; PG8_SCHED;
            PG8_LDA(At, 0, 1); PG8_STAGE(PG8_SB(0, 0), b2, voffB); PG8_STAGE(PG8_SB(0, 1), b2 + hstep, voffB); PG8_STAGE(PG8_SA(0, 0), a2, voffA);
            PG8_WAIT_V(8); PG8_WAIT_L(0); PG8_BAR; PG8_MMA(1, 0, At, B0); PG8_MMA(1, 1, At, B1); PG8_BAR; PG8_SCHED;
            PG8_LDB(B0, 1, 0); PG8_LDB(B1, 1, 1); PG8_SCHED; PG8_LDA(At, 1, 0); PG8_STAGE(PG8_SA(0, 1), a2 + hstep, voffA);
            PG8_WAIT_V(8); PG8_WAIT_L(0); PG8_BAR; PG8_MMA(0, 0, At, B0); PG8_MMA(0, 1, At, B1); PG8_BAR; PG8_SCHED;
            PG8_LDA(At, 1, 1); PG8_STAGE(PG8_SB(1, 0), b3, voffB); PG8_STAGE(PG8_SB(1, 1), b3 + hstep, voffB); PG8_STAGE(PG8_SA(1, 0), a3, voffA);
            PG8_WAIT_V(8); PG8_WAIT_L(0); PG8_BAR; PG8_MMA(1, 0, At, B0); PG8_MMA(1, 1, At, B1); PG8_BAR; PG8_SCHED;
            } else {
            PG8_LDB(B0, 0, 0); PG8_SCHED; PG8_LDA(At, 0, 0); PG8_STAGE(PG8_SA(1, 1), a1 + hstep, voffA);
            PG8_WAIT_L(8); PG8_BAR; PG8_WAIT_L(0); PG8_MMA(0, 0, At, B0); PG8_BAR; PG8_SCHED;
            PG8_LDB(B1, 0, 1); PG8_STAGE(PG8_SB(0, 0), b2, voffB);
            PG8_BAR; PG8_WAIT_L(0); PG8_MMA(0, 1, At, B1); PG8_BAR;
            PG8_LDA(At, 0, 1); PG8_STAGE(PG8_SA(0, 0), a2, voffA);
            PG8_BAR; PG8_WAIT_L(0); PG8_MMA(1, 0, At, B0); PG8_BAR; PG8_SCHED;
            PG8_STAGE(PG8_SB(0, 1), b2 + hstep, voffB);
            PG8_WAIT_V(6); PG8_BAR; PG8_MMA(1, 1, At, B1); PG8_BAR;
            PG8_LDB(B0, 1, 0); PG8_SCHED; PG8_LDA(At, 1, 0); PG8_STAGE(PG8_SA(0, 1), a2 + hstep, voffA);
            PG8_WAIT_L(8); PG8_BAR; PG8_WAIT_L(0); PG8_MMA(0, 0, At, B0); PG8_BAR; PG8_SCHED;
            PG8_LDB(B1, 1, 1); PG8_STAGE(PG8_SB(1, 0), b3, voffB);
            PG8_BAR; PG8_WAIT_L(0); PG8_MMA(0, 1, At, B1); PG8_BAR;
            PG8_LDA(At, 1, 1); PG8_STAGE(PG8_SA(1, 0), a3, voffA);
            PG8_BAR; PG8_WAIT_L(0); PG8_MMA(1, 0, At, B0); PG8_BAR; PG8_SCHED;
            PG8_STAGE(PG8_SB(1, 1), b3 + hstep, voffB);
            PG8_WAIT_V(6); PG8_BAR; PG8_MMA(1, 1, At, B1); PG8_BAR;
            }
        }
        if constexpr (ALIGN_EPI) { if (wr == 0) PG8_BAR; }
        { int te = threadIdx.x; asm volatile("" : "+v"(te));
          E(acc, cur, wr, wc, te & 15, (te & 63) >> 4); } S.done(cur);
        if (!has_next) break;
#pragma unroll
        for (int a = 0; a < 2; ++a)
#pragma unroll
            for (int b = 0; b < 2; ++b)
#pragma unroll
                for (int m = 0; m < 4; ++m)
#pragma unroll
                    for (int n = 0; n < 2; ++n) acc[a][b][m][n] = (f32x4){0.f, 0.f, 0.f, 0.f};
        cur = nxt; cA = nA; cB = nB; ++ui;
        if constexpr (ALIGN_EPI) { if (wr == 1) PG8_BAR; }
    }
    PG8_WAIT_V(0);
    if constexpr (!ALIGN_EPI) { if (wr == 0) PG8_BAR; }
    PG8_BAR;
#undef voffB
#undef PG8_SA
#undef PG8_SB
#undef PG8_STAGE
#undef PG8_LDA
#undef PG8_LDB
#undef PG8_MMA
#undef PG8_WAIT_V
#undef PG8_WAIT_L
#undef PG8_BAR
#undef PG8_SCHED
}
}

namespace att {
constexpr float SCALE = 0.08838834764831845f;
constexpr float THR = 8.f;
constexpr int NW = 8, QBLK = 32, KVBLK = 64, QB = NW * QBLK;
constexpr int SHM_V = KVBLK * HD * 2, SHM_K = KVBLK * HD * 2;
#define KSWZ(row, colB) ((row) * 256 + ((colB) ^ (((row) & 7) << 4)))
#define SBAR() __builtin_amdgcn_sched_barrier(0)
__device__ __forceinline__ int v_st(int k, int c) { const int kk = (k & ~0xC) | ((k & 4) << 1) | ((k & 8) >> 1); return ((kk >> 3) * 4 + (c >> 5)) * 512 + ((kk & 7) * 32 + (c & 31)) * 2; }
__device__ __forceinline__ int v_rd_base(int lane) { return ((lane & 3) << 3) | (((lane >> 2) & 3) << 6) | (((lane >> 4) & 1) << 5) | (((lane >> 5) & 1) << 8); }
constexpr int v_rd_off(int d0, int ks, int half) { return d0 * 512 + ks * 4096 + half * 2048; }
__device__ __forceinline__ int crow(int r, int hi) { return (r & 3) + 8 * (r >> 2) + 4 * hi; }
__device__ __forceinline__ unsigned cvtpk(float lo, float hi) { unsigned r; asm volatile("v_cvt_pk_bf16_f32 %0, %1, %2" : "=v"(r) : "v"(lo), "v"(hi)); return r; }
__device__ __forceinline__ bf16x8 ld8(const bf16* p) { return *reinterpret_cast<const bf16x8*>(p); }
__device__ __forceinline__ void mask_tile(f32x16& p0, f32x16& p1, int dq, unsigned W) {
    const float NEG = -__builtin_inff();
#pragma unroll
    for (int r = 0; r < 16; ++r) {
        const int c = (r & 3) + 8 * (r >> 2);
        if ((unsigned)(dq - c) >= W) p0[r] = NEG;
        if ((unsigned)(dq - c - 32) >= W) p1[r] = NEG;
    }
}
__device__ __forceinline__ void partialSM(f32x16& p0, f32x16& p1, float& m_reg, float& mn, float& alpha) {
    float pmax = p0[0]; for (int r = 1; r < 16; ++r) pmax = fmaxf(pmax, p0[r]); for (int r = 0; r < 16; ++r) pmax = fmaxf(pmax, p1[r]);
    { auto rr = __builtin_amdgcn_permlane32_swap(__float_as_uint(pmax), __float_as_uint(pmax), false, false);
      pmax = fmaxf(__uint_as_float(rr[0]), __uint_as_float(rr[1])); }
    constexpr float C2 = 1.4426950408889634f * SCALE;
    if (__builtin_expect(__all((pmax - m_reg) * SCALE <= THR), 1)) { mn = m_reg; alpha = 1.f; }
    else { mn = fmaxf(m_reg, pmax); alpha = __builtin_amdgcn_exp2f((m_reg - mn) * C2); m_reg = mn; }
    const float mnL = -mn * C2;
    for (int r = 0; r < 16; ++r) p0[r] = fmaf(p0[r], C2, mnL); for (int r = 0; r < 16; ++r) p1[r] = fmaf(p1[r], C2, mnL);
    for (int r = 0; r < 16; ++r) p0[r] = __builtin_amdgcn_exp2f(p0[r]);
}
__device__ __forceinline__ void finishSM(f32x16& p0, f32x16& p1, float alpha, float& l_reg, bf16x8& pa0, bf16x8& pa1, bf16x8& pa2, bf16x8& pa3) {
    for (int r = 0; r < 16; ++r) p1[r] = __builtin_amdgcn_exp2f(p1[r]);
    float ps = 0; for (int r = 0; r < 16; ++r) ps += p0[r]; for (int r = 0; r < 16; ++r) ps += p1[r];
    { auto rr = __builtin_amdgcn_permlane32_swap(__float_as_uint(ps), __float_as_uint(ps), false, false);
      ps = __uint_as_float(rr[0]) + __uint_as_float(rr[1]); }
    l_reg = l_reg * alpha + ps;
#define PK4(P, B_, OUT) do { unsigned a0 = cvtpk(P[B_+0], P[B_+1]), a1 = cvtpk(P[B_+2], P[B_+3]);                          \
        unsigned b0 = cvtpk(P[B_+4], P[B_+5]), b1 = cvtpk(P[B_+6], P[B_+7]);                                             \
        auto r0 = __builtin_amdgcn_permlane32_swap(a0, b0, false, false); auto r1 = __builtin_amdgcn_permlane32_swap(a1, b1, false, false); \
        u32x4 w = {r0[0], r1[0], r0[1], r1[1]}; OUT = *reinterpret_cast<bf16x8*>(&w); } while (0)
    PK4(p0, 0, pa0); PK4(p0, 8, pa1); PK4(p1, 0, pa2); PK4(p1, 8, pa3);
#undef PK4
}
template <int KB, bool SK>
__device__ __forceinline__ void qkt(f32x16& p0, f32x16& p1, const char* K_lds, int r32, int hi, const bf16x8* qr, bool act) {
    if (SK && !act) { const float NEG = -__builtin_inff();
#pragma unroll
        for (int r = 0; r < 16; ++r) { p0[r] = NEG; p1[r] = NEG; } return; }
    p0 = f32x16{}; p1 = f32x16{};
    const char* kb[4];
#pragma unroll
    for (int dd = 0; dd < 4; ++dd) kb[dd] = K_lds + KB * SHM_K + KSWZ(r32, (dd * 16 + hi * 8) * 2);
#pragma unroll
    for (int d0 = 0; d0 < 8; ++d0) { const char* a = kb[d0 & 3] + (d0 >> 2) * 128;
        bf16x8 b0 = *reinterpret_cast<const bf16x8*>(a);
        bf16x8 b1 = *reinterpret_cast<const bf16x8*>(a + 32 * 256);
        p0 = __builtin_amdgcn_mfma_f32_32x32x16_bf16(b0, qr[d0], p0, 0, 0, 0);
        p1 = __builtin_amdgcn_mfma_f32_32x32x16_bf16(b1, qr[d0], p1, 0, 0, 0); }
}
#define TRRD(dst, off) asm volatile("ds_read_b64_tr_b16 %0, %1 offset:%2" : "=&v"(dst) : "v"(vb0), "i"(off) : "memory")
#define PV_D0(VBv, d0, oo) do { s16x4 l0, l1, l2, l3, h0, h1, h2, h3; constexpr int b_ = (VBv) * att::SHM_V + att::v_rd_off(d0, 0, 0); \
        TRRD(l0, b_); TRRD(h0, b_ + 2048); TRRD(l1, b_ + 4096); TRRD(h1, b_ + 6144); TRRD(l2, b_ + 8192); TRRD(h2, b_ + 10240); TRRD(l3, b_ + 12288); TRRD(h3, b_ + 14336); \
        asm volatile("s_waitcnt lgkmcnt(0)" ::: "memory"); SBAR(); \
        oo = __builtin_amdgcn_mfma_f32_32x32x16_bf16(pa0, (bf16x8){l0[0], l0[1], l0[2], l0[3], h0[0], h0[1], h0[2], h0[3]}, oo, 0, 0, 0);   \
        oo = __builtin_amdgcn_mfma_f32_32x32x16_bf16(pa1, (bf16x8){l1[0], l1[1], l1[2], l1[3], h1[0], h1[1], h1[2], h1[3]}, oo, 0, 0, 0);   \
        oo = __builtin_amdgcn_mfma_f32_32x32x16_bf16(pa2, (bf16x8){l2[0], l2[1], l2[2], l2[3], h2[0], h2[1], h2[2], h2[3]}, oo, 0, 0, 0);   \
        oo = __builtin_amdgcn_mfma_f32_32x32x16_bf16(pa3, (bf16x8){l3[0], l3[1], l3[2], l3[3], h3[0], h3[1], h3[2], h3[3]}, oo, 0, 0, 0); } while (0)

struct BlockRef { int tok0, h, br, P0, dil; };
struct Bases { const bf16* Z; bf16* OB; float* LSE; };
#define BR_PIN(r) ((r).dil * ZP)
#define BR_ZB(r) (B.Z + (size_t)(r).tok0 * ZP + (r).h * HD)
#define BR_Q(r) (BR_ZB(r) + (size_t)(r).P0 * BR_PIN(r))
#define BR_K(r) (BR_ZB(r) + AW)
#define BR_V(r) (BR_ZB(r) + 2 * AW)
#define PVT_D0(VBv, d0, oo) do { s16x4 l0, l1, l2, l3, h0, h1, h2, h3; constexpr int b_ = (VBv) * att::SHM_V + att::v_rd_off(d0, 0, 0); \
        TRRD(l0, b_); TRRD(h0, b_ + 2048); TRRD(l1, b_ + 4096); TRRD(h1, b_ + 6144); TRRD(l2, b_ + 8192); TRRD(h2, b_ + 10240); TRRD(l3, b_ + 12288); TRRD(h3, b_ + 14336); \
        asm volatile("s_waitcnt lgkmcnt(0)" ::: "memory"); SBAR(); \
        oo = __builtin_amdgcn_mfma_f32_32x32x16_bf16((bf16x8){l0[0], l0[1], l0[2], l0[3], h0[0], h0[1], h0[2], h0[3]}, pa0, oo, 0, 0, 0);   \
        oo = __builtin_amdgcn_mfma_f32_32x32x16_bf16((bf16x8){l1[0], l1[1], l1[2], l1[3], h1[0], h1[1], h1[2], h1[3]}, pa1, oo, 0, 0, 0);   \
        oo = __builtin_amdgcn_mfma_f32_32x32x16_bf16((bf16x8){l2[0], l2[1], l2[2], l2[3], h2[0], h2[1], h2[2], h2[3]}, pa2, oo, 0, 0, 0);   \
        oo = __builtin_amdgcn_mfma_f32_32x32x16_bf16((bf16x8){l3[0], l3[1], l3[2], l3[3], h3[0], h3[1], h3[2], h3[3]}, pa3, oo, 0, 0, 0); } while (0)
template <int VB>
__device__ __forceinline__ void pvt_tile(f32x16* o, int vb0, bf16x8 pa0, bf16x8 pa1, bf16x8 pa2, bf16x8 pa3, bool act) {
    if (!act) return;
    PVT_D0(VB, 0, o[0]); PVT_D0(VB, 1, o[1]); PVT_D0(VB, 2, o[2]); PVT_D0(VB, 3, o[3]);
}
constexpr int QST_OFF = 2 * SHM_V + 3 * SHM_K;
__device__ __forceinline__ void swa_item(const BlockRef& cur, const BlockRef& nxt, const Bases& B, char* lds, LAS unsigned char* ldsl, const int tid, const bool first) {
    constexpr int W = 129;
    const int wid = __builtin_amdgcn_readfirstlane(tid >> 6), lane = tid & 63, r32 = lane & 31, hi = lane >> 5;
    const int kb0 = cur.P0 - 128;
    const int qlo = cur.P0 + wid * QBLK, qm = qlo + r32 - 4 * hi;
    char* K_lds = lds + 2 * SHM_V;
    const int vb0 = (int)(uintptr_t)lds + v_rd_base(lane);
    int kpk[2], vpk[2];
#pragma unroll
    for (int i = 0; i < 2; ++i) { const int c = 2 * wid + i;
        const int row = 4 * c + (lane >> 4), c16 = lane & 15; kpk[i] = row * 256 + ((c16 ^ (row & 7)) * 8);
        const int q = c * 64 + lane, sub = q >> 5, r = q & 31, kk = (sub >> 2) * 8 + (r >> 2), c8 = (sub & 3) * 4 + (r & 3), k = (kk & ~0xC) | ((kk & 4) << 1) | ((kk & 8) >> 1);
        vpk[i] = k * 256 + c8 * 8; }
    const unsigned kdst = (unsigned)(2 * SHM_V) + (unsigned)wid * 2048u, vdst = (unsigned)wid * 2048u, qdst = (unsigned)QST_OFF + (unsigned)wid * 8192u;
#define DMA_KX(ref, t) do { const int pin_ = BR_PIN(ref); const int kbc_ = (ref).P0 - 128 + 64 * (t); const bf16* g_ = BR_K(ref) + (long)(kbc_ < 0 ? 0 : kbc_) * pin_; _Pragma("unroll") for (int _i = 0; _i < 2; ++_i) \
        __builtin_amdgcn_global_load_lds((const unsigned*)(g_ + (unsigned)((kpk[_i] >> 8) * pin_ + (kpk[_i] & 255))), (LAS unsigned*)(ldsl + kdst + ((t) % 3) * SHM_K + _i * 1024), 16, 0, 0); } while (0)
#define DMA_VX(ref, t) do { const int pin_ = BR_PIN(ref); const int kbc_ = (ref).P0 - 128 + 64 * (t); const bf16* g_ = BR_V(ref) + (long)(kbc_ < 0 ? 0 : kbc_) * pin_; _Pragma("unroll") for (int _i = 0; _i < 2; ++_i) \
        __builtin_amdgcn_global_load_lds((const unsigned*)(g_ + (unsigned)((vpk[_i] >> 8) * pin_ + (vpk[_i] & 255))), (LAS unsigned*)(ldsl + vdst + ((t) % 2) * SHM_V + _i * 1024), 16, 0, 0); } while (0)
#define DMA_Q(ref) do { const int pin_ = BR_PIN(ref); const bf16* g_ = BR_Q(ref) + (size_t)(wid * QBLK) * pin_; _Pragma("unroll") for (int j_ = 0; j_ < 8; ++j_) { const int row_ = 4 * j_ + (lane >> 4); \
        __builtin_amdgcn_global_load_lds((const unsigned*)(g_ + (unsigned)(row_ * pin_ + (((lane & 15) ^ (row_ & 15)) * 8))), (LAS unsigned*)(ldsl + qdst + j_ * 1024), 16, 0, 0); } } while (0)
#define WAITV(n) asm volatile("s_waitcnt vmcnt(" #n ")" ::: "memory")
#define BARV(n) do { WAITV(n); __builtin_amdgcn_s_barrier(); asm volatile("" ::: "memory"); } while (0)
    if (first) { DMA_Q(cur); DMA_KX(cur, 0); DMA_VX(cur, 0); DMA_KX(cur, 1); WAITV(6); } else { WAITV(9); }
    bf16x8 qr[8];
#pragma unroll
    for (int d0 = 0; d0 < 8; ++d0) qr[d0] = *(const bf16x8*)(lds + qdst + r32 * 256 + (((2 * d0 + hi) ^ (r32 & 15)) << 4));
    asm volatile("s_waitcnt lgkmcnt(0)" ::: "memory");
    float m_reg = -1e30f, l_reg = 0; f32x16 o[4] = {};
#define RESC(a) do { if (__any((a) < 1.f)) { for (int d_ = 0; d_ < 4; ++d_) for (int r = 0; r < 16; ++r) o[d_][r] *= (a); } } while (0)
#define KBASE(t) (kb0 + 64 * (t))
#define ACT(t) (KBASE(t) >= 0 && KBASE(t) <= qlo + QBLK - 1 && KBASE(t) + KVBLK - 1 >= qlo - W + 1)
#define MASKT(P0_, P1_, t) do { const int kb_ = KBASE(t); if (kb_ + KVBLK - 1 > qlo || kb_ <= qlo + QBLK - 1 - W) mask_tile(P0_, P1_, qm - kb_, (unsigned)W); } while (0)
#define STEP(t, WAITS, ISSUE) do {                                                                                           \
        WAITS; ISSUE;                                                                                                        \
        if (ACT(t)) { f32x16 p0, p1; float mn, al; bf16x8 pa0, pa1, pa2, pa3;                                                \
            SBAR(); qkt<(t) % 3, false>(p0, p1, K_lds, r32, hi, qr, true);                                                  \
            MASKT(p0, p1, (t)); partialSM(p0, p1, m_reg, mn, al); RESC(al);                                                  \
            finishSM(p0, p1, al, l_reg, pa0, pa1, pa2, pa3); SBAR();                                                         \
            pvt_tile<(t) % 2>(o, vb0, pa0, pa1, pa2, pa3, true); } } while (0)
    STEP(0, do { if (first) BARV(2); else BARV(9); } while (0), do { DMA_VX(cur, 1); DMA_KX(cur, 2); } while (0));
    STEP(1, BARV(2), do { DMA_VX(cur, 2); DMA_KX(cur, 3); } while (0));
    STEP(2, BARV(2), do { DMA_VX(cur, 3); DMA_KX(cur, 4); } while (0));
    STEP(3, BARV(2), do { DMA_VX(cur, 4); DMA_KX(cur, 5); } while (0));
    STEP(4, BARV(2), do { DMA_VX(cur, 5); DMA_KX(nxt, 0); } while (0));
    STEP(5, BARV(2), do { DMA_VX(nxt, 0); DMA_KX(nxt, 1); DMA_Q(nxt); } while (0));
    const float inv = __builtin_amdgcn_rcpf(l_reg);
    const int pout = cur.dil * AW;
    char* Orow = (char*)(B.OB + ((size_t)cur.br * MTOK + cur.tok0) * AW + cur.h * HD + (size_t)(cur.P0 + wid * QBLK + r32) * pout) + hi * 16;
#pragma unroll
    for (int d0 = 0; d0 < 4; ++d0)
#pragma unroll
        for (int pr = 0; pr < 2; ++pr) {
            unsigned ax = cvtpk(o[d0][8 * pr + 0] * inv, o[d0][8 * pr + 1] * inv), ay = cvtpk(o[d0][8 * pr + 2] * inv, o[d0][8 * pr + 3] * inv);
            unsigned bx = cvtpk(o[d0][8 * pr + 4] * inv, o[d0][8 * pr + 5] * inv), by = cvtpk(o[d0][8 * pr + 6] * inv, o[d0][8 * pr + 7] * inv);
            auto rx = __builtin_amdgcn_permlane32_swap(ax, bx, false, false); auto ry = __builtin_amdgcn_permlane32_swap(ay, by, false, false);
            u32x4 w = {rx[0], ry[0], rx[1], ry[1]};
            *(u32x4*)(Orow + 16 * (4 * d0 + 2 * pr)) = w; }
    if (hi == 0) B.LSE[((size_t)cur.br * MTOK + cur.tok0) * NAH + cur.h + (size_t)(cur.P0 + wid * QBLK + r32) * (cur.dil * NAH)] = m_reg * SCALE + __builtin_amdgcn_logf(l_reg) * 0.6931471805599453f;
#undef RESC
#undef KBASE
#undef ACT
#undef MASKT
#undef STEP
#undef DMA_KX
#undef DMA_VX
#undef DMA_Q
#undef WAITV
#undef BARV
}
}

constexpr int NWAVES = 8;
constexpr size_t MiB = 1u << 20;
constexpr size_t WS_CTL = 0, CTL_ZERO_BYTES = 3 * MiB + 512 * 1024;
constexpr size_t WS_SSQ = 1 * MiB;
constexpr size_t WS_BIASR = 2 * MiB + 256 * 1024;
constexpr size_t WS_MODV = 8 * MiB;
constexpr size_t WS_ROPE = 9 * MiB;
constexpr size_t WS_SGUW = 13 * MiB;
constexpr size_t WS_LSE = 14 * MiB;
constexpr size_t WS_PART = 20 * MiB;
constexpr size_t WS_W = 44 * MiB;
constexpr size_t SZ_WINE = (size_t)MIXIN * DM * 2, SZ_WSQ = (size_t)DM * DM * 2, SZ_WINO = (size_t)CIN * DM * 2, SZ_WGU = (size_t)NGU * DM * 2, SZ_WD = (size_t)DM * DFF * 2;
constexpr size_t WS_WINE = WS_W, WS_WOUTE = WS_WINE + 2 * SZ_WINE, WS_WINO = WS_WOUTE + 2 * SZ_WSQ, WS_WOUTO = WS_WINO + 2 * SZ_WINO, WS_WGU = WS_WOUTO + 2 * SZ_WSQ, WS_WD = WS_WGU + 4 * SZ_WGU;
constexpr size_t WS_H = 432 * MiB;
constexpr size_t WS_Z = 560 * MiB;
constexpr size_t WS_AO = 944 * MiB;
constexpr size_t WS_OB = 1072 * MiB;
constexpr size_t WS_XB = 1360 * MiB;
constexpr size_t WS_END = 1488 * MiB;
constexpr size_t BIAS_INE = 0, BIAS_INO = BIAS_INE + 2 * 4 * MIXIN, BIAS_GU = BIAS_INO + 2 * 4 * CIN, BIAS_END = BIAS_GU + 4 * 4 * NGU;
static_assert(WS_SSQ + 9 * (size_t)MTOK * sizeof(u64) <= WS_BIASR && WS_BIASR + BIAS_END * sizeof(i64) <= CTL_ZERO_BYTES, "zeroed region");
static_assert(WS_WD + 4 * SZ_WD <= WS_H, "weights fit");
constexpr int CW_TMO = 0, CW_BAR = 4096;
constexpr int RING_OFF = 0, RING_BYTES = 131072;
constexpr int LDSCTL_OFF = 147456, MISC_OFF = LDSCTL_OFF + 320;
constexpr int LDS_BYTES = 155648;

typedef GAS unsigned gu32;
#define RLX_AGENT __ATOMIC_RELAXED, __HIP_MEMORY_SCOPE_AGENT
#define LDS_WAIT() asm volatile("s_waitcnt lgkmcnt(0)" ::: "memory")
#define VM_WAIT() asm volatile("s_waitcnt vmcnt(0)" ::: "memory")

#define XB_TMO      128
#define XB_XCNT(j)  (256  + 64 * (j))
#define XB_XSUB(j)  (1280 + 64 * (j))
#define XB_XGEN(j)  (2304 + 64 * (j))
#define XB_TOP      3328
#define XB_TOPGEN   3392
#define XCD_BAR_WORDS 3456
#define XB_SPIN_CAP (1u << 18)
__device__ __forceinline__ unsigned xb_ld(unsigned* p)              { return __hip_atomic_load(p, __ATOMIC_RELAXED, __HIP_MEMORY_SCOPE_AGENT); }
__device__ __forceinline__ unsigned xb_add(unsigned* p, unsigned v) { return __hip_atomic_fetch_add(p, v, __ATOMIC_RELAXED, __HIP_MEMORY_SCOPE_AGENT); }
__device__ __forceinline__ unsigned xb_xcc_id() { return (unsigned)__builtin_amdgcn_s_getreg((3 << 11) | 20) & 0xFu; }
#define XB_SPIN(cond, bar) do { unsigned _sp = 0; while (cond) { __builtin_amdgcn_s_sleep(1); \
    if ((++_sp & 255u) == 0u) { if (xb_ld(&(bar)[XB_TMO])) break; if (_sp > XB_SPIN_CAP) { atomicAdd(&(bar)[XB_TMO], 1u); break; } } } } while (0)
struct XcdBarrier { unsigned* bar; unsigned x; volatile LAS unsigned* st; };
__device__ __forceinline__ XcdBarrier xcd_barrier_post(unsigned* bar, volatile LAS unsigned* st) {
    XcdBarrier b; b.bar = bar; b.x = xb_xcc_id(); b.st = st;
    if (threadIdx.x == 0) (void)xb_add(&bar[XB_XCNT(b.x)], 1u);
    return b;
}
__device__ __forceinline__ void xcd_barrier_complete(unsigned* bar, unsigned x, unsigned& nloc, unsigned& nx) {
    const unsigned G = gridDim.x * gridDim.y * gridDim.z;
    unsigned sum, cnt, mine, sp = 0u;
    for (;;) {
        sum = 0u; cnt = 0u; mine = 0u;
#pragma unroll
        for (unsigned j = 0; j < 16; ++j) { const unsigned c = xb_ld(&bar[XB_XCNT(j)]); sum += c; cnt += (c > 0u) ? 1u : 0u; mine = (j == x) ? c : mine; }
        if (sum == G) break;
        __builtin_amdgcn_s_sleep(1);
        if ((++sp & 255u) == 0u) { if (xb_ld(&bar[XB_TMO])) break; if (sp > XB_SPIN_CAP) { atomicAdd(&bar[XB_TMO], 1u); break; } }
    }
    nloc = mine > 0u ? mine : 1u; nx = cnt > 0u ? cnt : 1u;
}
__device__ __forceinline__ void xcd_barrier(const XcdBarrier& b) {
    asm volatile("s_waitcnt vmcnt(0)" ::: "memory");
    __syncthreads();
    if (threadIdx.x == 0) {
        unsigned* bar = b.bar;
        __builtin_amdgcn_s_waitcnt(0);
        unsigned nloc = b.st[0], nx = b.st[1];
        if (nloc == 0u) { xcd_barrier_complete(bar, b.x, nloc, nx); b.st[0] = nloc; b.st[1] = nx; }
        const unsigned old = xb_add(&bar[XB_XSUB(b.x)], 1u);
        const unsigned gen = old / nloc;
        if (old + 1u == (gen + 1u) * nloc) {
            __builtin_amdgcn_fence(__ATOMIC_RELEASE, "agent");
            asm volatile("s_waitcnt vmcnt(0)" ::: "memory");
            const unsigned og = xb_add(&bar[XB_TOP], 1u);
            const unsigned tg = og / nx;
            if (og + 1u == (tg + 1u) * nx) xb_add(&bar[XB_TOPGEN], 1u);
            else XB_SPIN(xb_ld(&bar[XB_TOPGEN]) == tg, bar);
            __builtin_amdgcn_fence(__ATOMIC_ACQUIRE, "agent");
            xb_add(&bar[XB_XGEN(b.x)], 1u);
            asm volatile("s_waitcnt vmcnt(0)" ::: "memory");
        } else {
            XB_SPIN(xb_ld(&bar[XB_XGEN(b.x)]) == gen, bar);
            __builtin_amdgcn_fence(__ATOMIC_ACQUIRE, "agent");
            asm volatile("s_waitcnt vmcnt(0)" ::: "memory");
        }
    }
    __syncthreads();
}

struct Args { const void* in[18]; float* out; unsigned char* ws; int ph_lo, ph_hi, dry, pad; };
enum { I_X = 0, I_C, I_POS, I_ADAW, I_ADAB, I_NMIX, I_NFFN, I_ABWIN, I_SGUW, I_SGUB, I_ABWOUT, I_CWIN, I_CW, I_CWOUT, I_FG, I_FU, I_FD, I_FNORM };

__device__ __forceinline__ float wave_sum(float v) {
    v += swz_xor<1>(v); v += swz_xor<2>(v); v += swz_xor<4>(v); v += swz_xor<8>(v); v += swz_xor<16>(v);
    auto rr = __builtin_amdgcn_permlane32_swap(__float_as_uint(v), __float_as_uint(v), false, false);
    return __uint_as_float(rr[0]) + __uint_as_float(rr[1]);
}
__device__ __forceinline__ unsigned pk2(float lo, float hi) { return cvt_pk_bf16(lo, hi); }

__device__ __forceinline__ void p0_transpose_item(const float* W, int ldn, int col0, int k0, bf16* WT, int K, int drow0, bool perm, LAS float* scr, int lane, const float* shv, i64* biasr, int bN) {
    float wv[32];
#pragma unroll
    for (int i = 0; i < 32; ++i) { const int kk = 2 * i + (lane >> 5); wv[i] = W[(size_t)(k0 + kk) * ldn + col0 + (lane & 31)]; }
#pragma unroll
    for (int i = 0; i < 32; ++i) { const int kk = 2 * i + (lane >> 5); scr[kk * 33 + (lane & 31)] = wv[i]; }
    if (biasr) {
        LAS float* scs = scr + 64 * 33;
#pragma unroll
        for (int b = 0; b < 4; ++b) scs[b * 64 + lane] = shv[(size_t)b * 6 * DM + k0 + lane];
    }
    LDS_WAIT(); asm volatile("" ::: "memory");
    if (biasr) {
        const LAS float* scs = scr + 64 * 33;
        const int rho = lane & 31, kh = lane >> 5, src = perm ? pg8::perm32(rho) : rho;
        float a0 = 0.f, a1 = 0.f, a2 = 0.f, a3 = 0.f;
#pragma unroll 8
        for (int k2 = 0; k2 < 32; ++k2) { const int kk = 32 * kh + k2; const float w = scr[kk * 33 + src];
            a0 += w * scs[kk]; a1 += w * scs[64 + kk]; a2 += w * scs[128 + kk]; a3 += w * scs[192 + kk]; }
        a0 = half_sum(a0); a1 = half_sum(a1); a2 = half_sum(a2); a3 = half_sum(a3);
        if (lane < 32) { i64* bp = biasr + rho;
            __hip_atomic_fetch_add(bp, (i64)(a0 * BIAS_SCALE), __ATOMIC_RELAXED, __HIP_MEMORY_SCOPE_AGENT); __hip_atomic_fetch_add(bp + bN, (i64)(a1 * BIAS_SCALE), __ATOMIC_RELAXED, __HIP_MEMORY_SCOPE_AGENT);
            __hip_atomic_fetch_add(bp + 2 * bN, (i64)(a2 * BIAS_SCALE), __ATOMIC_RELAXED, __HIP_MEMORY_SCOPE_AGENT); __hip_atomic_fetch_add(bp + 3 * bN, (i64)(a3 * BIAS_SCALE), __ATOMIC_RELAXED, __HIP_MEMORY_SCOPE_AGENT); }
    }
    const int c = lane & 7;
#pragma unroll
    for (int j = 0; j < 4; ++j) { const int rho = (lane >> 3) + 8 * j; const int src = perm ? pg8::perm32(rho) : rho; const LAS float* s = scr + (8 * c) * 33 + src;
        u32x4 o; o.x = pk2(s[0 * 33], s[1 * 33]); o.y = pk2(s[2 * 33], s[3 * 33]); o.z = pk2(s[4 * 33], s[5 * 33]); o.w = pk2(s[6 * 33], s[7 * 33]);
        *(GAS u32x4*)(WT + (size_t)(drow0 + rho) * K + k0 + 8 * c) = o; }
    LDS_WAIT(); asm volatile("" ::: "memory");
}

__device__ __forceinline__ void prenorm_rows(int gw, int lane, const float* xin, bf16* XB, bf16* outp, const float* A, int bstride, u64* ssq) {
    const int r0 = gw * 16, b = r0 / SEQ;
    f32x4 av[8];
#pragma unroll
    for (int j = 0; j < 8; ++j) av[j] = *(const f32x4*)(A + (size_t)b * bstride + 4 * (lane + 64 * j));
    for (int rb = 0; rb < 16; rb += 2) {
      f32x4 vq[2][8];
#pragma unroll
      for (int rr = 0; rr < 2; ++rr)
#pragma unroll
        for (int j = 0; j < 8; ++j) vq[rr][j] = ((const f32x4*)(xin + (size_t)(r0 + rb + rr) * DM) + lane)[64 * j];
#pragma unroll
      for (int rr = 0; rr < 2; ++rr) { const size_t row = (size_t)(r0 + rb + rr);
        f32x4 v[8]; float ss = 0.f;
#pragma unroll
        for (int j = 0; j < 8; ++j) v[j] = vq[rr][j];
#pragma unroll
        for (int j = 0; j < 8; ++j) { u32x2 w; w.x = pk2(v[j].x, v[j].y); w.y = pk2(v[j].z, v[j].w); *((u32x2*)(XB + row * DM) + lane + 64 * j) = w;
            v[j] = (f32x4){bf_lo(w.x), bf_hi(w.x), bf_lo(w.y), bf_hi(w.y)}; ss += (v[j].x * v[j].x + v[j].y * v[j].y) + (v[j].z * v[j].z + v[j].w * v[j].w); }
        ss = wave_sum(ss);
        if (lane == 0) ssq[row] = (u64)(ss * SSQ_SCALE + 0.5f);
#pragma unroll
        for (int j = 0; j < 8; ++j) { const f32x4 o = v[j] * av[j]; u32x2 w; w.x = pk2(o.x, o.y); w.y = pk2(o.z, o.w); *((u32x2*)(outp + row * DM) + lane + 64 * j) = w; }
      } }
}
__device__ __forceinline__ void final_rows(int gw, int lane, const bf16* XB, float* outp, const float* A, const u64* ssq) {
    f32x4 av[4][2];
#pragma unroll
    for (int j = 0; j < 4; ++j) { av[j][0] = *(const f32x4*)(A + 8 * (lane + 64 * j)); av[j][1] = *(const f32x4*)(A + 8 * (lane + 64 * j) + 4); }
    for (int rb = 0; rb < 16; rb += 4) {
        u32x4 xq[4][4]; u64 sq[4];
#pragma unroll
        for (int r = 0; r < 4; ++r) { const size_t row = (size_t)gw * 16 + rb + r; sq[r] = ssq[row];
#pragma unroll
            for (int j = 0; j < 4; ++j) xq[r][j] = *((const u32x4*)(XB + row * DM) + lane + 64 * j); }
#pragma unroll
        for (int r = 0; r < 4; ++r) { const size_t row = (size_t)gw * 16 + rb + r; const float rstd = 1.0f / sqrtf((float)sq[r] * (1.0f / (SSQ_SCALE * DM)) + EPS);
#pragma unroll
            for (int j = 0; j < 4; ++j) { const u32x4 xi = xq[r][j];
                float* op = outp + row * DM + 8 * (lane + 64 * j);
                *(f32x4*)op = (f32x4){bf_lo(xi.x), bf_hi(xi.x), bf_lo(xi.y), bf_hi(xi.y)} * rstd * av[j][0];
                *(f32x4*)(op + 4) = (f32x4){bf_lo(xi.z), bf_hi(xi.z), bf_lo(xi.w), bf_hi(xi.w)} * rstd * av[j][1]; } }
    }
}


typedef __attribute__((address_space(4))) const char kargc;
__device__ __forceinline__ const void* karg(int idx) {
    asm volatile("" : "+s"(idx));
    kargc* kp = (kargc*)__builtin_amdgcn_kernarg_segment_ptr();
    return *(const void* __attribute__((address_space(4))) const*)(kp + (size_t)idx * 8);
}
#define KIN(i) karg(i)
#define KOUT() ((float*)karg(18))
#define KWS() ((unsigned char*)karg(19))

__device__ __forceinline__ att::BlockRef att_mkref(int L, int G) {
    const int rnd = L / G, w = L - rnd * G; const int xx = (w + rnd) & 31; const int bh = (rnd / 3) * 8 + (w >> 5), br = rnd % 3;
    const int dsh = 2 * br, nqb = 32 >> dsh;
    const int rr = xx / nqb, qb = xx % nqb, b = bh / NAH, h = bh % NAH;
    att::BlockRef R; R.tok0 = b * SEQ + rr; R.h = h; R.br = br; R.P0 = qb * att::QB; R.dil = 1 << dsh;
    return R;
}

__global__ void __launch_bounds__(NWAVES * 64, 2) mega_fwd(Args args) {
    extern __shared__ __attribute__((aligned(16))) unsigned char lds[];
    LAS unsigned char* ldsl = (LAS unsigned char*)lds;
    volatile LAS unsigned* MISC = (volatile LAS unsigned*)(ldsl + MISC_OFF);
    const int tid0 = threadIdx.x, wave = __builtin_amdgcn_readfirstlane(tid0 >> 6);
#define OPAQUE_TID() int tid = threadIdx.x; asm volatile("" : "+v"(tid)); const int lane = tid & 63; (void)lane
    const int G = gridDim.x; const int bx = blockIdx.x; const int vcu = (G % 8 == 0) ? (bx % 8) * (G / 8) + bx / 8 : bx;
    const int gw = vcu * NWAVES + wave, NGW = G * NWAVES;
    gu32* ctl = (gu32*)(args.ws + WS_CTL);
    for (int u = tid0; u < (LDS_BYTES - LDSCTL_OFF) / 4; u += NWAVES * 64) ((LAS unsigned*)(ldsl + LDSCTL_OFF))[u] = 0u;
    __syncthreads();
    XcdBarrier bar; bar.bar = (unsigned*)(ctl + CW_BAR); bar.x = 0; bar.st = nullptr;
    if (!MK_PER_PHASE) bar = xcd_barrier_post((unsigned*)(ctl + CW_BAR), MISC + 8);
    const int lo = args.ph_lo, hi = args.ph_hi;
#define IN(k) (lo <= (k) && (k) < hi)
#define SEAM(k) do { if (!MK_PER_PHASE && (k) + 1 < hi) xcd_barrier(bar); } while (0)

    if (IN(0)) { OPAQUE_TID(); unsigned char* ws = KWS(); float* PART = (float*)(ws + WS_PART);
        { const float* cin = (const float*)KIN(I_C); const float* adaw = (const float*)KIN(I_ADAW);
          for (int it = gw; it < 4 * 32 * 48; it += NGW) { const int ng = it % 48, kc = (it / 48) % 32, l = it / (48 * 32);
              const int k0 = 64 * kc, n0 = 256 * ng;
              float ca[4];
#pragma unroll
              for (int b = 0; b < 4; ++b) ca[b] = silu_f(cin[b * DM + k0 + lane]);
              f32x4 ac[4];
#pragma unroll
              for (int b = 0; b < 4; ++b) ac[b] = (f32x4){0.f, 0.f, 0.f, 0.f};
              const float* wp = adaw + ((size_t)l * DM + k0) * (6 * DM) + n0 + 4 * lane;
#pragma unroll 16
              for (int kk = 0; kk < 64; ++kk) { const f32x4 w = *(const f32x4*)(wp + (size_t)kk * (6 * DM));
#pragma unroll
                  for (int b = 0; b < 4; ++b) { const float s = __uint_as_float(__builtin_amdgcn_readlane(__float_as_uint(ca[b]), kk)); ac[b] += w * s; } }
#pragma unroll
              for (int b = 0; b < 4; ++b) *(f32x4*)(PART + ((size_t)((kc * 4 + l) * 4 + b)) * (6 * DM) + n0 + 4 * lane) = ac[b];
          } }
        { const int* pos = (const int*)KIN(I_POS); float* ROPE = (float*)(ws + WS_ROPE);
          for (int e = vcu * 512 + tid; e < MTOK * 16; e += G * 512) { const int row = e >> 4, i = e & 15;
              const double invf = exp2(-(double)i * (18.931568569324174 / 16.0));
              const double rev = (double)pos[row] * invf * 0.15915494309189535;
              const float fr = (float)(rev - floor(rev));
              ROPE[(size_t)row * 32 + i] = __builtin_amdgcn_cosf(fr); ROPE[(size_t)row * 32 + 16 + i] = __builtin_amdgcn_sinf(fr); } }
        { const float* sw = (const float*)KIN(I_SGUW); bf16* SGUW = (bf16*)(ws + WS_SGUW);
          for (int e = vcu * 512 + tid; e < 2 * 4 * 128 * 128; e += G * 512) { const int s = e & 127, t = (e >> 7) & 127;
              SGUW[e] = (bf16)(cvt_pk_bf16(s <= t ? sw[e] : 0.f, 0.f) & 0xffffu); } }
    }
    SEAM(0);
    if (IN(1)) { OPAQUE_TID(); unsigned char* ws = KWS(); float* PART = (float*)(ws + WS_PART); float* MODV = (float*)(ws + WS_MODV);
        const float* adab = (const float*)KIN(I_ADAB); const float* nmix = (const float*)KIN(I_NMIX); const float* nffn = (const float*)KIN(I_NFFN);
        for (int e = vcu * 512 + tid; e < 6 * 4 * 4 * DM; e += G * 512) { const int col = e % DM, b = (e / DM) % 4, l = (e / (4 * DM)) % 4, ch = e / (16 * DM);
            float pv[32];
#pragma unroll
            for (int kc = 0; kc < 32; ++kc) pv[kc] = PART[((size_t)((kc * 4 + l) * 4 + b)) * (6 * DM) + ch * DM + col];
            float sm = adab[l * 6 * DM + ch * DM + col];
#pragma unroll
            for (int kc = 0; kc < 32; ++kc) sm += pv[kc];
            const int slot = (ch == 0) ? 1 : (ch == 1) ? 0 : (ch == 3) ? 4 : (ch == 4) ? 3 : ch;
            float val = sm;
            if (ch == 1) val = nmix[l * DM + col] * (1.0f + sm);
            if (ch == 4) val = nffn[l * DM + col] * (1.0f + sm);
            MODV[((size_t)(l * 4 + b) * 6 + slot) * DM + col] = val; }
    }
    SEAM(1);
    if (IN(2)) { OPAQUE_TID(); unsigned char* ws = KWS(); const float* MODVc = (const float*)(ws + WS_MODV); i64* BIASR = (i64*)(ws + WS_BIASR);
        { LAS float* scr = (LAS float*)(ldsl + RING_OFF + wave * 16384);
          constexpr int C0 = 2 * 176 * 32, C1 = 2 * 64 * 32, C2 = 2 * 192 * 32, C3 = 2 * 64 * 32, C4 = 4 * 352 * 32, C5 = 4 * 64 * 88;
          constexpr int NIT = C0 + C1 + C2 + C3 + C4 + C5;
          for (int it = gw; it < NIT; it += NGW) { int r = it;
              if (r < C0) { const int i = r / (176 * 32), rem = r % (176 * 32), kb = rem / 176, gd = rem % 176;
                  p0_transpose_item((const float*)KIN(I_ABWIN) + (size_t)i * DM * MIXIN, MIXIN, 32 * gd, 64 * kb, (bf16*)(ws + WS_WINE + i * SZ_WINE), DM, 32 * gd, gd >= 96, scr, lane, MODVc + ((size_t)(2 * i) * 4 * 6 + 1) * DM, BIASR + BIAS_INE + (size_t)i * 4 * MIXIN + 32 * gd, MIXIN); continue; } r -= C0;
              if (r < C1) { const int i = r / (64 * 32), rem = r % (64 * 32), kb = rem / 64, gd = rem % 64;
                  p0_transpose_item((const float*)KIN(I_ABWOUT) + (size_t)i * DM * DM, DM, 32 * gd, 64 * kb, (bf16*)(ws + WS_WOUTE + i * SZ_WSQ), DM, 32 * gd, true, scr, lane, nullptr, nullptr, 0); continue; } r -= C1;
              if (r < C2) { const int i = r / (192 * 32), rem = r % (192 * 32), kb = rem / 192, gd = rem % 192; const int t = gd >> 3, w = gd & 7;
                  const int col0 = (t < 8) ? 32 * gd : ((w < 4) ? 2048 + 128 * (t - 8) + 32 * w : 4096 + 128 * (t - 8) + 32 * (w - 4));
                  p0_transpose_item((const float*)KIN(I_CWIN) + (size_t)i * DM * CIN, CIN, col0, 64 * kb, (bf16*)(ws + WS_WINO + i * SZ_WINO), DM, 32 * gd, true, scr, lane, MODVc + ((size_t)(2 * i + 1) * 4 * 6 + 1) * DM, BIASR + BIAS_INO + (size_t)i * 4 * CIN + 32 * gd, CIN); continue; } r -= C2;
              if (r < C3) { const int i = r / (64 * 32), rem = r % (64 * 32), kb = rem / 64, gd = rem % 64;
                  p0_transpose_item((const float*)KIN(I_CWOUT) + (size_t)i * DM * DM, DM, 32 * gd, 64 * kb, (bf16*)(ws + WS_WOUTO + i * SZ_WSQ), DM, 32 * gd, true, scr, lane, nullptr, nullptr, 0); continue; } r -= C3;
              if (r < C4) { const int l = r / (352 * 32), rem = r % (352 * 32), kb = rem / 352, gd = rem % 352; const int t = gd >> 3, w = gd & 7;
                  const float* src = (const float*)KIN((w < 4) ? I_FG : I_FU);
                  p0_transpose_item(src + (size_t)l * DM * DFF, DFF, 128 * t + 32 * (w & 3), 64 * kb, (bf16*)(ws + WS_WGU + l * SZ_WGU), DM, 32 * gd, true, scr, lane, MODVc + ((size_t)l * 4 * 6 + 4) * DM, BIASR + BIAS_GU + (size_t)l * 4 * NGU + 32 * gd, NGU); continue; } r -= C4;
              { const int l = r / (64 * 88), rem = r % (64 * 88), kb = rem / 64, gd = rem % 64;
                  p0_transpose_item((const float*)KIN(I_FD) + (size_t)l * DFF * DM, DM, 32 * gd, 64 * kb, (bf16*)(ws + WS_WD + l * SZ_WD), DFF, 32 * gd, true, scr, lane, nullptr, nullptr, 0); }
          } }
        prenorm_rows(gw, lane, (const float*)KIN(I_X), (bf16*)(ws + WS_XB), (bf16*)(ws + WS_H), MODVc, 6 * DM, (u64*)(ws + WS_SSQ) + (size_t)8 * MTOK);
    }
    SEAM(2);

    for (int layer = 0; layer < 4; ++layer) {
        const int pb = 3 + 8 * layer, li = layer >> 1; const bool even_layer = (layer & 1) == 0;
#define PH_SETUP() OPAQUE_TID(); unsigned char* ws = KWS(); const float* mv = (const float*)(ws + WS_MODV) + (size_t)layer * 4 * 6 * DM; (void)mv
        if (IN(pb + 1)) { PH_SETUP(); bf16* Hb = (bf16*)(ws + WS_H); bf16* Zb = (bf16*)(ws + WS_Z);
            if (even_layer) {
                pg8::Gemm g{Hb, (const bf16*)(ws + WS_WINE + li * SZ_WINE), MTOK, MIXIN, DM}; pg8::StaticOrder S; S.init(MTOK, MIXIN, G, bx);
                pg8::EpiInE E{Zb, (const float*)(ws + WS_ROPE), NormIn{(const u64*)(ws + WS_SSQ) + (size_t)(layer == 0 ? 8 : 2 * layer - 1) * MTOK, (const i64*)(ws + WS_BIASR) + BIAS_INE + (size_t)li * 4 * MIXIN, MIXIN, ldsl + LDSCTL_OFF + 1024}};
                pg8::gemm_phase<pg8::EpiInE, pg8::StaticOrder, true, true>(ldsl + RING_OFF, g, S, E, tid);
            } else {
                pg8::Gemm g{Hb, (const bf16*)(ws + WS_WINO + li * SZ_WINO), MTOK, CIN, DM}; pg8::StaticOrder S; S.init(MTOK, CIN, G, bx);
                pg8::EpiInO E{Zb, Zb + (size_t)MTOK * DM, NormIn{(const u64*)(ws + WS_SSQ) + (size_t)(2 * layer - 1) * MTOK, (const i64*)(ws + WS_BIASR) + BIAS_INO + (size_t)li * 4 * CIN, CIN, ldsl + LDSCTL_OFF + 1024}};
                pg8::gemm_phase<pg8::EpiInO, pg8::StaticOrder, true, true>(ldsl + RING_OFF, g, S, E, tid);
            }
        }
        SEAM(pb + 1);
        if (IN(pb + 2)) { PH_SETUP(); bf16* Zb = (bf16*)(ws + WS_Z); bf16* AO = (bf16*)(ws + WS_AO);
            if (even_layer) {
                {   constexpr int NITEM = 3 * 48 * 32; bf16* OB = (bf16*)(ws + WS_OB); float* LSE = (float*)(ws + WS_LSE);
                    const att::Bases BS{Zb, OB, LSE};
                    if (vcu < NITEM) { att::BlockRef cur = att_mkref(vcu, G); bool first = true;
                        for (int L = vcu; L < NITEM; L += G) { const att::BlockRef nxt = (L + G < NITEM) ? att_mkref(L + G, G) : cur;
                            att::swa_item(cur, nxt, BS, (char*)lds + RING_OFF, ldsl + RING_OFF, tid, first); cur = nxt; first = false; } }
                }
                VM_WAIT(); __syncthreads();
                {   const bf16* sgw = (const bf16*)(ws + WS_SGUW) + (size_t)li * 4 * 128 * 128; const float* sgb = (const float*)KIN(I_SGUB) + (size_t)li * 4 * 128;
                    char* V_lds = (char*)lds + RING_OFF;
                    int tid2 = threadIdx.x; asm volatile("" : "+v"(tid2)); const int lane2 = tid2 & 63;
                    const int r32 = lane2 & 31, hi2 = lane2 >> 5, sr = tid2 >> 4, sc = (tid2 & 15) * 8;
                    for (int s = vcu; s < 4 * 64 * 4; s += G) { const int g = s & 3, n = (s >> 2) & 63, b = s >> 8;
                        const size_t row0 = (size_t)b * SEQ + n * 128;
                        const int tb = (wave & 3) * 32, ch = wave >> 2;
                        bf16x8 vst[4];
#pragma unroll
                        for (int p = 0; p < 4; ++p) vst[p] = att::ld8(Zb + (row0 + 32 * p + sr) * ZP + 5120 + g * 128 + sc);
                        const bf16* wrow = sgw + ((size_t)g * 128 + tb + r32) * 128 + 8 * hi2;
                        bf16x8 wa[8];
#pragma unroll
                        for (int i = 0; i < 8; ++i) wa[i] = att::ld8(wrow + 16 * i);
                        const size_t rowt = row0 + tb + r32;
                        const bf16* up = Zb + rowt * ZP + 4608 + g * 128 + ch * 64 + 4 * hi2;
                        u32x2 uv[2][4];
#pragma unroll
                        for (int e = 0; e < 2; ++e)
#pragma unroll
                            for (int rg = 0; rg < 4; ++rg) uv[e][rg] = *(const u32x2*)(up + e * 32 + 8 * rg);
                        const float bias = sgb[g * 128 + tb + r32];
#pragma unroll
                        for (int p = 0; p < 4; ++p) { const int k = 32 * p + sr; *(bf16x8*)(V_lds + (k >> 6) * att::SHM_V + att::v_st(k & 63, sc)) = vst[p]; }
                        __syncthreads();
                        f32x16 o0 = {}, o1 = {};
                        const int vb0 = (int)(uintptr_t)V_lds + att::v_rd_base(lane2) + ch * 1024;
                        { bf16x8 pa0 = wa[0], pa1 = wa[1], pa2 = wa[2], pa3 = wa[3];
                          PVT_D0(0, 0, o0); PVT_D0(0, 1, o1); }
                        if (tb >= 64) { bf16x8 pa0 = wa[4], pa1 = wa[5], pa2 = wa[6], pa3 = wa[7];
                          PVT_D0(1, 0, o0); PVT_D0(1, 1, o1); }
                        bf16* op = AO + rowt * DM + AW + g * 128 + ch * 64 + 4 * hi2;
#pragma unroll
                        for (int e = 0; e < 2; ++e)
#pragma unroll
                            for (int rg = 0; rg < 4; ++rg) { const u32x2 u2 = uv[e][rg]; float m4[4];
#pragma unroll
                                for (int j = 0; j < 4; ++j) m4[j] = (e ? o1[4 * rg + j] : o0[4 * rg + j]) + bias;
                                u32x2 w; w.x = cvt_pk_bf16(bf_lo(u2.x) * m4[0], bf_hi(u2.x) * m4[1]); w.y = cvt_pk_bf16(bf_lo(u2.y) * m4[2], bf_hi(u2.y) * m4[3]);
                                *(u32x2*)(op + e * 32 + 8 * rg) = w; }
                        __syncthreads();
                    }
                }
            } else {
                const bf16* GBp = Zb; const bf16* Yp = Zb + (size_t)MTOK * DM; const float* cw = (const float*)KIN(I_CW) + (size_t)li * 3 * DM;
                const int r0 = gw * 16; const bool first = (r0 % SEQ) == 0;
                for (int cc = 0; cc < 4; ++cc) { const int col = 512 * cc + 8 * lane;
                    float w0[8], w1[8], w2[8], ym2[8], ym1[8];
#pragma unroll
                    for (int j = 0; j < 8; ++j) { w0[j] = cw[col + j]; w1[j] = cw[DM + col + j]; w2[j] = cw[2 * DM + col + j]; ym2[j] = 0.f; ym1[j] = 0.f; }
                    if (!first) { const u32x4 a = *(const u32x4*)(Yp + (size_t)(r0 - 2) * DM + col), c = *(const u32x4*)(Yp + (size_t)(r0 - 1) * DM + col);
#pragma unroll
                        for (int q = 0; q < 4; ++q) { ym2[2 * q] = bf_lo(a[q]); ym2[2 * q + 1] = bf_hi(a[q]); ym1[2 * q] = bf_lo(c[q]); ym1[2 * q + 1] = bf_hi(c[q]); } }
                    { constexpr int rb = 0;
                      u32x4 yq[16], gq[16];
#pragma unroll
                      for (int r = 0; r < 16; ++r) { const size_t off = (size_t)(r0 + rb + r) * DM + col; yq[r] = *(const u32x4*)(Yp + off); gq[r] = *(const u32x4*)(GBp + off); }
#pragma unroll
                      for (int r = 0; r < 16; ++r) { const size_t off = (size_t)(r0 + rb + r) * DM + col;
                        const u32x4 yv = yq[r], gv = gq[r];
                        float y0[8], gb[8], o[8];
#pragma unroll
                        for (int q = 0; q < 4; ++q) { y0[2 * q] = bf_lo(yv[q]); y0[2 * q + 1] = bf_hi(yv[q]); gb[2 * q] = bf_lo(gv[q]); gb[2 * q + 1] = bf_hi(gv[q]); }
#pragma unroll
                        for (int j = 0; j < 8; ++j) { o[j] = gb[j] * (w0[j] * ym2[j] + w1[j] * ym1[j] + w2[j] * y0[j]); ym2[j] = ym1[j]; ym1[j] = y0[j]; }
                        u32x4 w; w.x = pk2(o[0], o[1]); w.y = pk2(o[2], o[3]); w.z = pk2(o[4], o[5]); w.w = pk2(o[6], o[7]);
                        *(u32x4*)(AO + off) = w; } }
                }
            }
        }
        SEAM(pb + 2);
        if (even_layer) {
            if (IN(pb + 3)) { PH_SETUP(); bf16* AO = (bf16*)(ws + WS_AO); const bf16* OB = (const bf16*)(ws + WS_OB); const float* LSE = (const float*)(ws + WS_LSE);
                for (int rb = 0; rb < 16; rb += 4) {
                  float lq[4][3][3]; u32x4 oq[4][3][3];
#pragma unroll
                  for (int rr = 0; rr < 4; ++rr) { const size_t row = (size_t)gw * 16 + rb + rr;
#pragma unroll
                      for (int j = 0; j < 3; ++j) { const int c = lane + 64 * j, h = c >> 4;
#pragma unroll
                          for (int b3 = 0; b3 < 3; ++b3) { lq[rr][j][b3] = LSE[(size_t)b3 * MTOK * NAH + row * NAH + h]; oq[rr][j][b3] = *(const u32x4*)(OB + (size_t)b3 * MTOK * AW + row * AW + 8 * c); } } }
#pragma unroll
                  for (int rr = 0; rr < 4; ++rr) { const size_t row = (size_t)gw * 16 + rb + rr;
#pragma unroll
                    for (int j = 0; j < 3; ++j) { const int c = lane + 64 * j;
                        const float l0 = lq[rr][j][0], l1 = lq[rr][j][1], l2 = lq[rr][j][2];
                        const float mx = fmaxf(l0, fmaxf(l1, l2)); float e0 = fast_exp(l0 - mx), e1 = fast_exp(l1 - mx), e2 = fast_exp(l2 - mx);
                        const float inv = 1.0f / (e0 + e1 + e2); e0 *= inv; e1 *= inv; e2 *= inv;
                        const u32x4 a = oq[rr][j][0], bq = oq[rr][j][1], cq = oq[rr][j][2];
                        u32x4 w;
#pragma unroll
                        for (int q = 0; q < 4; ++q) w[q] = pk2(e0 * bf_lo(a[q]) + e1 * bf_lo(bq[q]) + e2 * bf_lo(cq[q]), e0 * bf_hi(a[q]) + e1 * bf_hi(bq[q]) + e2 * bf_hi(cq[q]));
                        *(u32x4*)(AO + row * DM + 8 * c) = w; } } }
            }
            SEAM(pb + 3);
        }
        if (IN(pb + 4)) { PH_SETUP(); const bf16* AO = (const bf16*)(ws + WS_AO); bf16* xb = (bf16*)(ws + WS_XB); bf16* xw = args.dry ? (bf16*)(ws + WS_OB) : xb;
            const bf16* wo = even_layer ? (const bf16*)(ws + WS_WOUTE + li * SZ_WSQ) : (const bf16*)(ws + WS_WOUTO + li * SZ_WSQ);
            pg8::Gemm g{AO, wo, MTOK, DM, DM}; pg8::StaticOrder S; S.init(MTOK, DM, G, bx);
            pg8::EpiRes E{xb, xw, mv + 2 * DM, 6 * DM, (bf16*)(ws + WS_H), mv + 3 * DM, 6 * DM, (u64*)(ws + WS_SSQ) + (size_t)(2 * layer) * MTOK, ldsl + LDSCTL_OFF + 1024};
            pg8::gemm_phase<pg8::EpiRes, pg8::StaticOrder, true, true>(ldsl + RING_OFF, g, S, E, tid);
        }
        SEAM(pb + 4);
        if (IN(pb + 6)) { PH_SETUP(); const bf16* Hb = (const bf16*)(ws + WS_H); bf16* Zb = (bf16*)(ws + WS_Z);
            pg8::Gemm g{Hb, (const bf16*)(ws + WS_WGU + layer * SZ_WGU), MTOK, NGU, DM}; pg8::StaticOrder S; S.init(MTOK, NGU, G, bx);
            pg8::EpiGU E{Zb, NormIn{(const u64*)(ws + WS_SSQ) + (size_t)(2 * layer) * MTOK, (const i64*)(ws + WS_BIASR) + BIAS_GU + (size_t)layer * 4 * NGU, NGU, ldsl + LDSCTL_OFF + 1024}};
            pg8::gemm_phase<pg8::EpiGU, pg8::StaticOrder, true, true>(ldsl + RING_OFF, g, S, E, tid);
        }
        SEAM(pb + 6);
        if (IN(pb + 7)) { PH_SETUP(); const bf16* Zb = (const bf16*)(ws + WS_Z); bf16* xb = (bf16*)(ws + WS_XB); bf16* xw = args.dry ? (bf16*)(ws + WS_OB) : xb;
            pg8::Gemm g{Zb, (const bf16*)(ws + WS_WD + layer * SZ_WD), MTOK, DM, DFF}; pg8::StaticOrder S; S.init(MTOK, DM, G, bx);
            pg8::EpiRes E{xb, xw, mv + 5 * DM, 6 * DM, layer < 3 ? (bf16*)(ws + WS_H) : (bf16*)nullptr, mv + 4 * 6 * DM, 6 * DM, (u64*)(ws + WS_SSQ) + (size_t)(2 * layer + 1) * MTOK, ldsl + LDSCTL_OFF + 1024};
            pg8::gemm_phase<pg8::EpiRes, pg8::StaticOrder, true, true>(ldsl + RING_OFF, g, S, E, tid);
        }
        SEAM(pb + 7);
    }
    if (IN(35)) { OPAQUE_TID(); unsigned char* ws = KWS(); final_rows(gw, lane, (const bf16*)(ws + WS_XB), KOUT(), (const float*)KIN(I_FNORM), (const u64*)(ws + WS_SSQ) + (size_t)7 * MTOK); }
#undef IN
#undef SEAM
}

extern "C" void kernel_launch(void* const* d_in, const int* in_sizes, int n_in, void* d_out, int out_size, void* d_ws, size_t ws_size, hipStream_t stream) {
    static int grid = 0;
    if (grid == 0) {
        if (n_in != 18 || out_size != MTOK * DM || ws_size < WS_END) { fprintf(stderr, "kernel_launch: unexpected shapes (n_in %d, out %d, ws %zu; need ws >= %zu)\n", n_in, out_size, ws_size, (size_t)WS_END); grid = -1; return; }
        int dev = 0, cus = 0, per_cu = 0;
        if (hipGetDevice(&dev) != hipSuccess || hipDeviceGetAttribute(&cus, hipDeviceAttributeMultiprocessorCount, dev) != hipSuccess) { grid = -1; return; }
        if (hipFuncSetAttribute((const void*)mega_fwd, hipFuncAttributeMaxDynamicSharedMemorySize, LDS_BYTES) != hipSuccess) { fprintf(stderr, "kernel_launch: hipFuncSetAttribute failed\n"); grid = -1; return; }
        if (hipOccupancyMaxActiveBlocksPerMultiprocessor(&per_cu, (const void*)mega_fwd, NWAVES * 64, LDS_BYTES) != hipSuccess || per_cu < 1)
            fprintf(stderr, "kernel_launch: note: occupancy query reports %d workgroups per CU\n", per_cu);
        (void)hipGetLastError();
        grid = cus;
        if (grid != 256) fprintf(stderr, "kernel_launch: %d CUs (built for 256)\n", grid);
    }
    if (grid < 0) return;
    (void)in_sizes;
    if (hipMemsetAsync((char*)d_ws + WS_CTL, 0, CTL_ZERO_BYTES, stream) != hipSuccess) return;
    Args a{};
    for (int i = 0; i < 18; ++i) a.in[i] = d_in[i];
    a.out = (float*)d_out; a.ws = (unsigned char*)d_ws;
#if MK_PER_PHASE
    for (int p = 0; p < 36; ++p) { if (p >= 3 && p < 35) { const int k = (p - 3) % 8, l = (p - 3) / 8; if (k == 0 || k == 5 || (k == 3 && (l & 1))) continue; }
        a.ph_lo = p; a.ph_hi = p + 1; hipLaunchKernelGGL(mega_fwd, dim3(grid), dim3(NWAVES * 64), LDS_BYTES, stream, a); }
#else
    a.ph_lo = 0; a.ph_hi = 36;
    hipLaunchKernelGGL(mega_fwd, dim3(grid), dim3(NWAVES * 64), LDS_BYTES, stream, a);
    for (int r = 0; r < PROBE_REPS; ++r) { (void)hipMemsetAsync((char*)d_ws + WS_CTL, 0, CTL_ZERO_BYTES, stream);
        a.ph_lo = PROBE_LO; a.ph_hi = PROBE_HI; a.dry = PROBE_DRY; hipLaunchKernelGGL(mega_fwd, dim3(grid), dim3(NWAVES * 64), LDS_BYTES, stream, a); }
#endif
}
```

```cpp
#include <hip/hip_runtime.h>
#include <cstdio>
#include <cstdint>

#ifndef PROBE_REPS
#define PROBE_REPS 0
#define PROBE_LO 0
#define PROBE_HI 0
#define PROBE_DRY 0
#endif
#ifndef MK_PER_PHASE
#define MK_PER_PHASE 0
#endif

constexpr int BATCH = 4, SEQ = 8192, DM = 2048, MTOK = BATCH * SEQ, DFF = 5632, HD = 128, NAH = 12, AW = 1536, SW = 512, MIXIN = 5632, CIN = 6144, NGU = 2 * DFF;
constexpr int ZP = 5632;
constexpr float EPS = 1e-6f;

typedef unsigned short bf16;
typedef short bf16x8 __attribute__((ext_vector_type(8)));
typedef short s16x4 __attribute__((ext_vector_type(4)));
typedef float f32x4 __attribute__((ext_vector_type(4)));
typedef float f32x16 __attribute__((ext_vector_type(16)));
typedef float f32x2 __attribute__((ext_vector_type(2)));
typedef unsigned u32x4 __attribute__((ext_vector_type(4)));
typedef unsigned u32x2 __attribute__((ext_vector_type(2)));
#define LAS __attribute__((address_space(3)))
#define GAS __attribute__((address_space(1)))

__device__ __forceinline__ unsigned cvt_pk_bf16(float lo, float hi) { unsigned r; asm volatile("v_cvt_pk_bf16_f32 %0, %1, %2" : "=v"(r) : "v"(lo), "v"(hi)); return r; }
__device__ __forceinline__ float bf_lo(unsigned w) { return __uint_as_float(w << 16); }
__device__ __forceinline__ float bf_hi(unsigned w) { return __uint_as_float(w & 0xffff0000u); }
__device__ __forceinline__ float fast_exp(float x) { return __builtin_amdgcn_exp2f(x * 1.4426950408889634f); }
__device__ __forceinline__ float gelu_tanh(float x) {
    const float t = x * (1.0f + 0.044715f * x * x) * (-2.0f * 0.7978845608028654f * 1.4426950408889634f);
    return x * __builtin_amdgcn_rcpf(1.0f + __builtin_amdgcn_exp2f(t));
}
__device__ __forceinline__ float silu_f(float x) { return x * __builtin_amdgcn_rcpf(1.0f + __builtin_amdgcn_exp2f(x * -1.4426950408889634f)); }

template <int O> __device__ __forceinline__ float swz_xor(float v) { return __int_as_float(__builtin_amdgcn_ds_swizzle(__float_as_int(v), (O << 10) | 0x1f)); }
__device__ __forceinline__ float xor1(float v) { return __int_as_float(__builtin_amdgcn_update_dpp(0, __float_as_int(v), 0xB1, 0xf, 0xf, true)); }
__device__ __forceinline__ float half_sum(float v) { auto rr = __builtin_amdgcn_permlane32_swap(__float_as_uint(v), __float_as_uint(v), false, false); return __uint_as_float(rr[0]) + __uint_as_float(rr[1]); }
typedef unsigned u64; typedef int i64;
constexpr float SSQ_SCALE = 1024.0f, BIAS_SCALE = 1048576.0f;
struct NormIn { const u64* ssq; const i64* bias; int N; LAS unsigned char* stg;
    __device__ __forceinline__ void stage(int pm, int pn, int lane) const {
        __builtin_amdgcn_global_load_lds((const unsigned*)(ssq + (size_t)pm * 256 + lane * 4), (LAS unsigned*)stg, 16, 0, 0);
        __builtin_amdgcn_global_load_lds((const unsigned*)(bias + (size_t)(pm >> 5) * N + pn * 256 + lane * 4), (LAS unsigned*)(stg + 1024), 16, 0, 0); }
    __device__ __forceinline__ float rs(int rowl) const;
    __device__ __forceinline__ f32x4 bias4l(int coll) const;
};
__device__ __forceinline__ float rs_of(const u64* ssq, int row) { return __builtin_amdgcn_rsqf((float)ssq[row] * (1.0f / (SSQ_SCALE * DM)) + EPS); }
typedef int i32x4 __attribute__((ext_vector_type(4)));
__device__ __forceinline__ f32x4 bias4(const i64* p) { const i32x4 v = *(const i32x4*)p; return (f32x4){(float)v.x, (float)v.y, (float)v.z, (float)v.w} * (1.0f / BIAS_SCALE); }
__device__ __forceinline__ float NormIn::rs(int rowl) const { return __builtin_amdgcn_rsqf((float)((const LAS u64*)stg)[rowl] * (1.0f / (SSQ_SCALE * DM)) + EPS); }
__device__ __forceinline__ f32x4 NormIn::bias4l(int coll) const { const i32x4 v = *(const LAS i32x4*)(stg + 1024 + coll * 4); return (f32x4){(float)v.x, (float)v.y, (float)v.z, (float)v.w} * (1.0f / BIAS_SCALE); }
__device__ __forceinline__ void ssq_add(u64* p, float v) { __hip_atomic_fetch_add(p, (u64)(v * SSQ_SCALE + 0.5f), __ATOMIC_RELAXED, __HIP_MEMORY_SCOPE_AGENT); }

namespace pg8 {
constexpr int BM = 256, BK = 64, HALF = 128, HTB = HALF * BK * 2, STAGE_BYTES = 8 * HTB, NXCD = 8, WGM = 4;
__host__ __device__ __forceinline__ int lds_byte(int r, int c) { const int st = (r >> 4) * 2 + (c >> 5), rr = r & 15, cc = c & 31, ob = rr * 64 + cc * 2; return st * 1024 + (ob ^ (((ob >> 9) & 1) << 5)); }
__host__ __device__ __forceinline__ void stage_rc(int b, int& R, int& C) { const int st = b / 1024, sb = b % 1024, swz = sb ^ (((sb >> 9) & 1) << 5); R = (st >> 1) * 16 + swz / 64; C = (st & 1) * 32 + (swz % 64) / 2; }
__host__ __device__ __forceinline__ int perm32(int rho) { const int n = rho >> 4, i = rho & 15; return 8 * (i >> 2) + 4 * n + (i & 3); }

struct Unit { int pm, pn; };
struct Gemm { const bf16* A; const bf16* Bt; int M, N, K; };

struct StaticOrder {
    int nM, nN, nwg, G, c;
    __host__ __device__ void init(int M, int N, int G_, int c_) { nM = M / BM; nN = N / BM; nwg = nM * nN; G = G_; c = c_; }
    __host__ __device__ bool next(int i, Unit& u) const {
        const long L = (long)i * G + c; if (L >= nwg) return false;
        int wgid = (int)L; { const int q = nwg / NXCD, r = nwg % NXCD, xcd = wgid % NXCD, off = wgid / NXCD; wgid = (xcd < r ? xcd * (q + 1) : r * (q + 1) + (xcd - r) * q) + off; }
        const int nig = WGM * nN, gid = wgid / nig, fm = gid * WGM, gsz = (nM - fm) < WGM ? (nM - fm) : WGM;
        u.pm = fm + ((wgid % nig) % gsz); u.pn = (wgid % nig) / gsz; return true;
    }
    __device__ __forceinline__ void a_ready(const Unit&) const {}
    __device__ __forceinline__ void done(const Unit&) const {}
};

__device__ __forceinline__ void store8(bf16* p, f32x4 v0, f32x4 v1) {
    u32x4 w; w.x = cvt_pk_bf16(v0[0], v0[1]); w.y = cvt_pk_bf16(v0[2], v0[3]); w.z = cvt_pk_bf16(v1[0], v1[1]); w.w = cvt_pk_bf16(v1[2], v1[3]);
    *(u32x4*)p = w;
}

struct EpiInE {
    bf16* Z; const float* RT; NormIn nb;
    __device__ __forceinline__ void stage(const Unit& u, int lane) const { nb.stage(u.pm, u.pn, lane); }
    __device__ __forceinline__ void operator()(const f32x4 (&acc)[2][2][4][2], const Unit& u, int wr, int wc, int fr, int fq) const {
        const int row0 = u.pm * BM + wr * 64 + fr, col0 = u.pn * BM + wc * 32 + 8 * fq;
        f32x4 bv[2][2];
        { const int bp = wc * 32 + 4 * fq;
#pragma unroll
          for (int bj = 0; bj < 2; ++bj)
#pragma unroll
              for (int n = 0; n < 2; ++n) bv[bj][n] = nb.bias4l(bp + bj * HALF + n * 16); }
        if (u.pn < 12) {
            const bool rot = (wc == 0);
#pragma unroll
            for (int ai = 0; ai < 2; ++ai) {
                f32x4 csq[4], snq[4];
#pragma unroll
                for (int m = 0; m < 4; ++m) { csq[m] = (f32x4){1.f, 1.f, 1.f, 1.f}; snq[m] = (f32x4){0.f, 0.f, 0.f, 0.f}; }
                if (rot) {
#pragma unroll
                    for (int m = 0; m < 4; ++m) { const int row = row0 + ai * HALF + m * 16; csq[m] = *(const f32x4*)(RT + (size_t)row * 32 + 4 * fq); snq[m] = *(const f32x4*)(RT + (size_t)row * 32 + 16 + 4 * fq); } }
#pragma unroll
                for (int m = 0; m < 4; ++m) { const int row = row0 + ai * HALF + m * 16; bf16* rowp = Z + (size_t)row * ZP + col0; const float rs = nb.rs(row - u.pm * BM);
                    const f32x4 cs = csq[m], sn = snq[m];
#pragma unroll
                    for (int bj = 0; bj < 2; ++bj) { const f32x4 t1 = acc[ai][bj][m][0] * rs + bv[bj][0], t2 = acc[ai][bj][m][1] * rs + bv[bj][1];
                        store8(rowp + bj * HALF, t1 * cs - t2 * sn, t2 * cs + t1 * sn); } } }
        } else if (u.pn < 18) {
#pragma unroll
            for (int ai = 0; ai < 2; ++ai)
#pragma unroll
                for (int m = 0; m < 4; ++m) { const int row = row0 + ai * HALF + m * 16; bf16* rowp = Z + (size_t)row * ZP + col0; const float rs = nb.rs(row - u.pm * BM);
#pragma unroll
                    for (int bj = 0; bj < 2; ++bj) store8(rowp + bj * HALF, acc[ai][bj][m][0] * rs + bv[bj][0], acc[ai][bj][m][1] * rs + bv[bj][1]); }
        } else {
#pragma unroll
            for (int ai = 0; ai < 2; ++ai)
#pragma unroll
                for (int m = 0; m < 4; ++m) { const int row = row0 + ai * HALF + m * 16; bf16* rowp = Z + (size_t)row * ZP + col0; const float rs = nb.rs(row - u.pm * BM);
#pragma unroll
                    for (int bj = 0; bj < 2; ++bj) { f32x4 v0 = acc[ai][bj][m][0] * rs + bv[bj][0], v1 = acc[ai][bj][m][1] * rs + bv[bj][1];
#pragma unroll
                        for (int j = 0; j < 4; ++j) { v0[j] = gelu_tanh(v0[j]); v1[j] = gelu_tanh(v1[j]); }
                        store8(rowp + bj * HALF, v0, v1); } }
        }
    }
};
struct EpiInO {
    bf16* GB; bf16* Y; NormIn nb;
    __device__ __forceinline__ void stage(const Unit& u, int lane) const { nb.stage(u.pm, u.pn, lane); }
    __device__ __forceinline__ void operator()(const f32x4 (&acc)[2][2][4][2], const Unit& u, int wr, int wc, int fr, int fq) const {
        const int row0 = u.pm * BM + wr * 64 + fr;
        f32x4 bv[2][2];
        { const int bp = wc * 32 + 4 * fq;
#pragma unroll
          for (int bj = 0; bj < 2; ++bj)
#pragma unroll
              for (int n = 0; n < 2; ++n) bv[bj][n] = nb.bias4l(bp + bj * HALF + n * 16); }
        if (u.pn < 8) { const int col0 = u.pn * BM + wc * 32 + 8 * fq;
#pragma unroll
            for (int ai = 0; ai < 2; ++ai)
#pragma unroll
                for (int m = 0; m < 4; ++m) { const int row = row0 + ai * HALF + m * 16; bf16* rowp = GB + (size_t)row * DM + col0; const float rs = nb.rs(row - u.pm * BM);
#pragma unroll
                    for (int bj = 0; bj < 2; ++bj) store8(rowp + bj * HALF, acc[ai][bj][m][0] * rs + bv[bj][0], acc[ai][bj][m][1] * rs + bv[bj][1]); }
        } else { const int col0 = (u.pn - 8) * HALF + wc * 32 + 8 * fq;
#pragma unroll
            for (int ai = 0; ai < 2; ++ai)
#pragma unroll
                for (int m = 0; m < 4; ++m) { const int row = row0 + ai * HALF + m * 16; const float rs = nb.rs(row - u.pm * BM);
                    store8(Y + (size_t)row * DM + col0, (acc[ai][0][m][0] * rs + bv[0][0]) * (acc[ai][1][m][0] * rs + bv[1][0]), (acc[ai][0][m][1] * rs + bv[0][1]) * (acc[ai][1][m][1] * rs + bv[1][1])); }
        }
    }
};
struct EpiGU {
    bf16* Hd; NormIn nb;
    __device__ __forceinline__ void stage(const Unit& u, int lane) const { nb.stage(u.pm, u.pn, lane); }
    __device__ __forceinline__ void operator()(const f32x4 (&acc)[2][2][4][2], const Unit& u, int wr, int wc, int fr, int fq) const {
        const int row0 = u.pm * BM + wr * 64 + fr, col0 = u.pn * HALF + wc * 32 + 8 * fq;
        f32x4 bv[2][2];
        { const int bp = wc * 32 + 4 * fq;
#pragma unroll
          for (int bj = 0; bj < 2; ++bj)
#pragma unroll
              for (int n = 0; n < 2; ++n) bv[bj][n] = nb.bias4l(bp + bj * HALF + n * 16); }
#pragma unroll
        for (int ai = 0; ai < 2; ++ai)
#pragma unroll
            for (int m = 0; m < 4; ++m) { const int row = row0 + ai * HALF + m * 16; const float rs = nb.rs(row - u.pm * BM); f32x4 v0, v1;
                const f32x4 g0 = acc[ai][0][m][0] * rs + bv[0][0], g1 = acc[ai][0][m][1] * rs + bv[0][1], u0 = acc[ai][1][m][0] * rs + bv[1][0], u1 = acc[ai][1][m][1] * rs + bv[1][1];
#pragma unroll
                for (int j = 0; j < 4; ++j) { v0[j] = silu_f(g0[j]) * u0[j]; v1[j] = silu_f(g1[j]) * u1[j]; }
                store8(Hd + (size_t)row * ZP + col0, v0, v1); }
    }
};
struct EpiRes {
    const bf16* xin; bf16* xout; const float* gate; int gstride; bf16* Hn; const float* an; int astride; u64* ssq; LAS unsigned char* stg;
    __device__ __forceinline__ void stage(const Unit& u, int lane) const {
        __builtin_amdgcn_global_load_lds((const unsigned*)(gate + (size_t)(u.pm >> 5) * gstride + u.pn * BM + lane * 4), (LAS unsigned*)stg, 16, 0, 0);
        __builtin_amdgcn_global_load_lds((const unsigned*)((Hn ? an : gate) + (size_t)(u.pm >> 5) * astride + u.pn * BM + lane * 4), (LAS unsigned*)(stg + 1024), 16, 0, 0); }
    __device__ __forceinline__ void operator()(const f32x4 (&acc)[2][2][4][2], const Unit& u, int wr, int wc, int fr, int fq) const {
        const int row0 = u.pm * BM + wr * 64 + fr, col0 = u.pn * BM + wc * 32 + 8 * fq;
        const LAS unsigned char* gl = stg + (wc * 32 + 8 * fq) * 4;
        u32x4 xq[2][4][2];
#pragma unroll
        for (int ai = 0; ai < 2; ++ai)
#pragma unroll
            for (int m = 0; m < 4; ++m)
#pragma unroll
                for (int bj = 0; bj < 2; ++bj) xq[ai][m][bj] = *(const u32x4*)(xin + (size_t)(row0 + ai * HALF + m * 16) * DM + col0 + bj * HALF);
#pragma unroll
        for (int ai = 0; ai < 2; ++ai) {
#pragma unroll
            for (int m = 0; m < 4; ++m) { const int row = row0 + ai * HALF + m * 16; const size_t off = (size_t)row * DM + col0; float ps = 0.f;
#pragma unroll
                for (int bj = 0; bj < 2; ++bj) { const u32x4 xi = xq[ai][m][bj];
                    const f32x4 g0 = *(const LAS f32x4*)(gl + bj * HALF * 4), g1 = *(const LAS f32x4*)(gl + bj * HALF * 4 + 16);
                    const f32x4 x0 = (f32x4){bf_lo(xi.x), bf_hi(xi.x), bf_lo(xi.y), bf_hi(xi.y)} + g0 * acc[ai][bj][m][0];
                    const f32x4 x1 = (f32x4){bf_lo(xi.z), bf_hi(xi.z), bf_lo(xi.w), bf_hi(xi.w)} + g1 * acc[ai][bj][m][1];
                    u32x4 w; w.x = cvt_pk_bf16(x0[0], x0[1]); w.y = cvt_pk_bf16(x0[2], x0[3]); w.z = cvt_pk_bf16(x1[0], x1[1]); w.w = cvt_pk_bf16(x1[2], x1[3]);
                    *(u32x4*)(xout + off + bj * HALF) = w;
                    const f32x4 r0 = (f32x4){bf_lo(w.x), bf_hi(w.x), bf_lo(w.y), bf_hi(w.y)}, r1 = (f32x4){bf_lo(w.z), bf_hi(w.z), bf_lo(w.w), bf_hi(w.w)};
                    ps += ((r0[0] * r0[0] + r0[1] * r0[1]) + (r0[2] * r0[2] + r0[3] * r0[3])) + ((r1[0] * r1[0] + r1[1] * r1[1]) + (r1[2] * r1[2] + r1[3] * r1[3]));
                    if (Hn) { const f32x4 a0 = *(const LAS f32x4*)(gl + 1024 + bj * HALF * 4), a1 = *(const LAS f32x4*)(gl + 1024 + bj * HALF * 4 + 16); store8(Hn + off + bj * HALF, r0 * a0, r1 * a1); } }
                ps += swz_xor<16>(ps); ps = half_sum(ps); if (fq == 0) ssq_add(ssq + row, ps);
                asm volatile("" ::: "memory"); } }
    }
};

template <class Epi, class Sched, bool ALIGN_EPI = false, bool SP2 = false>
__device__ __forceinline__ void gemm_phase(LAS unsigned char* lds, const Gemm g, const Sched& S, const Epi& E, const int tid) {
    const int wid = __builtin_amdgcn_readfirstlane(tid >> 6), lane = tid & 63, wr = wid >> 2, wc = wid & 3, fr = lane & 15, fq = lane >> 4;
    const int K = g.K, nt = K / BK;
    unsigned voffA[2];
#pragma unroll
    for (int i = 0; i < 2; ++i) { int R, C; stage_rc(tid * 16 + i * 8192, R, C); voffA[i] = (unsigned)(R * K + C) * 2u; }
#define voffB voffA
    const size_t kstep = (size_t)(BK * 2);
    const size_t hstep = (size_t)HALF * K * 2;
    const size_t tstep = 2 * hstep;
    const unsigned ldsw = (unsigned)wid * 1024u;
    const int aoff = lds_byte(wr * 64 + fr, fq * 8), boff = lds_byte(wc * 32 + fr, fq * 8);
#define PG8_SA(b, h) (((b) * 2 + (h)) * HTB)
#define PG8_SB(b, h) ((4 + (b) * 2 + (h)) * HTB)
#define PG8_STAGE(bufoff, gbase, voff) do { _Pragma("unroll") for (int _i = 0; _i < 2; ++_i) \
        __builtin_amdgcn_global_load_lds((const unsigned*)((const char*)(gbase) + (voff)[_i]), (LAS unsigned*)(lds + (bufoff) + ldsw + _i * 8192), 16, 0, 0); } while (0)
#define PG8_LDA(dst, b, h) do { _Pragma("unroll") for (int m = 0; m < 4; ++m) _Pragma("unroll") for (int k = 0; k < 2; ++k) dst[m][k] = *(const LAS bf16x8*)(lds + PG8_SA(b, h) + aoff + m * 2048 + k * 1024); } while (0)
#define PG8_LDB(dst, b, h) do { _Pragma("unroll") for (int n = 0; n < 2; ++n) _Pragma("unroll") for (int k = 0; k < 2; ++k) dst[n][k] = *(const LAS bf16x8*)(lds + PG8_SB(b, h) + boff + n * 2048 + k * 1024); } while (0)
#define PG8_MMA1(ai, bj, At, Bt) do { _Pragma("unroll") for (int m = 0; m < 4; ++m) _Pragma("unroll") for (int n = 0; n < 2; ++n) _Pragma("unroll") for (int k = 0; k < 2; ++k) \
        acc[ai][bj][m][n] = __builtin_amdgcn_mfma_f32_16x16x32_bf16(Bt[n][k], At[m][k], acc[ai][bj][m][n], 0, 0, 0); } while (0)
#define PG8_MMA(ai, bj, At, Bt) do { if ((bj) == 0) __builtin_amdgcn_s_setprio(1); PG8_MMA1(ai, bj, At, Bt); if ((bj) == 1) __builtin_amdgcn_s_setprio(0); } while (0)
#define PG8_WAIT_V(n) asm volatile("s_waitcnt vmcnt(" #n ")" ::: "memory")
#define PG8_WAIT_L(n) asm volatile("s_waitcnt lgkmcnt(" #n ")" ::: "memory")
#define PG8_BAR __builtin_amdgcn_s_barrier()
#define PG8_SCHED __builtin_amdgcn_sched_barrier(0)
    Unit cur, nxt; int ui = 0;
    if (!S.next(0, cur)) return;
    f32x4 acc[2][2][4][2];
#pragma unroll
    for (int a = 0; a < 2; ++a)
#pragma unroll
        for (int b = 0; b < 2; ++b)
#pragma unroll
            for (int m = 0; m < 4; ++m)
#pragma unroll
                for (int n = 0; n < 2; ++n) acc[a][b][m][n] = (f32x4){0.f, 0.f, 0.f, 0.f};
    bf16x8 At[4][2], B0[2][2], B1[2][2];
    const char* cA = (const char*)g.A + (size_t)cur.pm * tstep; const char* cB = (const char*)g.Bt + (size_t)cur.pn * tstep;
    S.a_ready(cur);
    if constexpr (SP2) {
        PG8_STAGE(PG8_SB(0, 0), cB, voffB); PG8_STAGE(PG8_SB(0, 1), cB + hstep, voffB); PG8_STAGE(PG8_SA(0, 0), cA, voffA); PG8_STAGE(PG8_SA(0, 1), cA + hstep, voffA);
        if (wr == 1) PG8_BAR;
        PG8_WAIT_V(2); PG8_BAR;
        PG8_STAGE(PG8_SB(1, 0), cB + kstep, voffB); PG8_STAGE(PG8_SA(1, 0), cA + kstep, voffA); PG8_STAGE(PG8_SB(1, 1), cB + hstep + kstep, voffB);
        PG8_WAIT_V(6); PG8_BAR;
    } else {
        PG8_STAGE(PG8_SB(0, 0), cB, voffB); PG8_STAGE(PG8_SA(0, 0), cA, voffA); PG8_STAGE(PG8_SB(0, 1), cB + hstep, voffB); PG8_STAGE(PG8_SA(0, 1), cA + hstep, voffA);
        if (wr == 1) PG8_BAR;
        PG8_WAIT_V(4); PG8_BAR;
        PG8_STAGE(PG8_SB(1, 0), cB + kstep, voffB); PG8_STAGE(PG8_SA(1, 0), cA + kstep, voffA); PG8_STAGE(PG8_SB(1, 1), cB + hstep + kstep, voffB);
        PG8_WAIT_V(6); PG8_BAR;
    }
    for (;;) {
        const bool has_next = S.next(ui + 1, nxt);
        const char* nA = has_next ? (const char*)g.A + (size_t)nxt.pm * tstep : cA; const char* nB = has_next ? (const char*)g.Bt + (size_t)nxt.pn * tstep : cB;
        for (int t = 0; t < nt; t += 2) {
            const bool last = (t == nt - 2);
            const char* a1 = cA + (size_t)(t + 1) * kstep;
            const char* a2 = last ? nA : cA + (size_t)(t + 2) * kstep; const char* b2 = last ? nB : cB + (size_t)(t + 2) * kstep;
            const char* a3 = a2 + kstep; const char* b3 = b2 + kstep;
            if (last && has_next) S.a_ready(nxt);
            if (last && wid == 0) E.stage(cur, lane);
            if constexpr (SP2) {
            PG8_LDB(B0, 0, 0); PG8_LDB(B1, 0, 1); PG8_SCHED; PG8_LDA(At, 0, 0); PG8_STAGE(PG8_SA(1, 1), a1 + hstep, voffA);
            PG8_WAIT_V(8); PG8_WAIT_L(0); PG8_BAR; PG8_MMA(0, 0, At, B0); PG8_MMA(0, 1, At, B1); PG8_BAR; PG8_SCHED;
            PG8_LDA(At, 0, 1); PG8_STAGE(PG8_SB(0, 0), b2, voffB); PG8_STAGE(PG8_SB(0, 1), b2 + hstep, voffB); PG8_STAGE(PG8_SA(0, 0), a2, voffA);
            PG8_WAIT_V(8); PG8_WAIT_L(0); PG8_BAR; PG8_MMA(1, 0, At, B0); PG8_MMA(1, 1, At, B1); PG8_BAR; PG8_SCHED;
            PG8_LDB(B0, 1, 0); PG8_LDB(B1, 1, 1); PG8_SCHED; PG8_LDA(At, 1, 0); PG8_STAGE(PG8_SA(0, 1), a2 + hstep, voffA);
            PG8_WAIT_V(8); PG8_WAIT_L(0); PG8_BAR; PG8_MMA(0, 0, At, B0); PG8_MMA(0, 1, At, B1); PG8_BAR; PG8_SCHED;
            PG8_LDA(At, 1, 1); PG8_STAGE(PG8_SB(1, 0), b3, voffB); PG8_STAGE(PG8_SB(1, 1), b3 + hstep, voffB); PG8_STAGE(PG8_SA(1, 0), a3, voffA);
            PG8_WAIT_V(8); PG8_WAIT_L(0); PG8_BAR; PG8_MMA(1, 0, At, B0); PG8_MMA(1, 1, At, B1); PG8_BAR; PG8_SCHED;
            } else {
            PG8_LDB(B0, 0, 0); PG8_SCHED; PG8_LDA(At, 0, 0); PG8_STAGE(PG8_SA(1, 1), a1 + hstep, voffA);
            PG8_WAIT_L(8); PG8_BAR; PG8_WAIT_L(0); PG8_MMA(0, 0, At, B0); PG8_BAR; PG8_SCHED;
            PG8_LDB(B1, 0, 1); PG8_STAGE(PG8_SB(0, 0), b2, voffB);
            PG8_BAR; PG8_WAIT_L(0); PG8_MMA(0, 1, At, B1); PG8_BAR;
            PG8_LDA(At, 0, 1); PG8_STAGE(PG8_SA(0, 0), a2, voffA);
            PG8_BAR; PG8_WAIT_L(0); PG8_MMA(1, 0, At, B0); PG8_BAR; PG8_SCHED;
            PG8_STAGE(PG8_SB(0, 1), b2 + hstep, voffB);
            PG8_WAIT_V(6); PG8_BAR; PG8_MMA(1, 1, At, B1); PG8_BAR;
            PG8_LDB(B0, 1, 0); PG8_SCHED; PG8_LDA(At, 1, 0); PG8_STAGE(PG8_SA(0, 1), a2 + hstep, voffA);
            PG8_WAIT_L(8); PG8_BAR; PG8_WAIT_L(0); PG8_MMA(0, 0, At, B0); PG8_BAR; PG8_SCHED;
            PG8_LDB(B1, 1, 1); PG8_STAGE(PG8_SB(1, 0), b3, voffB);
            PG8_BAR; PG8_WAIT_L(0); PG8_MMA(0, 1, At, B1); PG8_BAR;
            PG8_LDA(At, 1, 1); PG8_STAGE(PG8_SA(1, 0), a3, voffA);
            PG8_BAR; PG8_WAIT_L(0); PG8_MMA(1, 0, At, B0); PG8_BAR; PG8_SCHED;
            PG8_STAGE(PG8_SB(1, 1), b3 + hstep, voffB);
            PG8_WAIT_V(6); PG8_BAR; PG8_MMA(1, 1, At, B1); PG8_BAR;
            }
        }
        if constexpr (ALIGN_EPI) { if (wr == 0) PG8_BAR; }
        { int te = threadIdx.x; asm volatile("" : "+v"(te));
          E(acc, cur, wr, wc, te & 15, (te & 63) >> 4); } S.done(cur);
        if (!has_next) break;
#pragma unroll
        for (int a = 0; a < 2; ++a)
#pragma unroll
            for (int b = 0; b < 2; ++b)
#pragma unroll
                for (int m = 0; m < 4; ++m)
#pragma unroll
                    for (int n = 0; n < 2; ++n) acc[a][b][m][n] = (f32x4){0.f, 0.f, 0.f, 0.f};
        cur = nxt; cA = nA; cB = nB; ++ui;
        if constexpr (ALIGN_EPI) { if (wr == 1) PG8_BAR; }
    }
    PG8_WAIT_V(0);
    if constexpr (!ALIGN_EPI) { if (wr == 0) PG8_BAR; }
    PG8_BAR;
#undef voffB
#undef PG8_SA
#undef PG8_SB
#undef PG8_STAGE
#undef PG8_LDA
#undef PG8_LDB
#undef PG8_MMA
#undef PG8_WAIT_V
#undef PG8_WAIT_L
#undef PG8_BAR
#undef PG8_SCHED
}
}

namespace att {
constexpr float SCALE = 0.08838834764831845f;
constexpr float THR = 8.f;
constexpr int NW = 8, QBLK = 32, KVBLK = 64, QB = NW * QBLK;
constexpr int SHM_V = KVBLK * HD * 2, SHM_K = KVBLK * HD * 2;
#define KSWZ(row, colB) ((row) * 256 + ((colB) ^ (((row) & 7) << 4)))
#define SBAR() __builtin_amdgcn_sched_barrier(0)
__device__ __forceinline__ int v_st(int k, int c) { const int kk = (k & ~0xC) | ((k & 4) << 1) | ((k & 8) >> 1); return ((kk >> 3) * 4 + (c >> 5)) * 512 + ((kk & 7) * 32 + (c & 31)) * 2; }
__device__ __forceinline__ int v_rd_base(int lane) { return ((lane & 3) << 3) | (((lane >> 2) & 3) << 6) | (((lane >> 4) & 1) << 5) | (((lane >> 5) & 1) << 8); }
constexpr int v_rd_off(int d0, int ks, int half) { return d0 * 512 + ks * 4096 + half * 2048; }
__device__ __forceinline__ int crow(int r, int hi) { return (r & 3) + 8 * (r >> 2) + 4 * hi; }
__device__ __forceinline__ unsigned cvtpk(float lo, float hi) { unsigned r; asm volatile("v_cvt_pk_bf16_f32 %0, %1, %2" : "=v"(r) : "v"(lo), "v"(hi)); return r; }
__device__ __forceinline__ bf16x8 ld8(const bf16* p) { return *reinterpret_cast<const bf16x8*>(p); }
__device__ __forceinline__ void mask_tile(f32x16& p0, f32x16& p1, int dq, unsigned W) {
    const float NEG = -__builtin_inff();
#pragma unroll
    for (int r = 0; r < 16; ++r) {
        const int c = (r & 3) + 8 * (r >> 2);
        if ((unsigned)(dq - c) >= W) p0[r] = NEG;
        if ((unsigned)(dq - c - 32) >= W) p1[r] = NEG;
    }
}
__device__ __forceinline__ void partialSM(f32x16& p0, f32x16& p1, float& m_reg, float& mn, float& alpha) {
    float pmax = p0[0]; for (int r = 1; r < 16; ++r) pmax = fmaxf(pmax, p0[r]); for (int r = 0; r < 16; ++r) pmax = fmaxf(pmax, p1[r]);
    { auto rr = __builtin_amdgcn_permlane32_swap(__float_as_uint(pmax), __float_as_uint(pmax), false, false);
      pmax = fmaxf(__uint_as_float(rr[0]), __uint_as_float(rr[1])); }
    constexpr float C2 = 1.4426950408889634f * SCALE;
    if (__builtin_expect(__all((pmax - m_reg) * SCALE <= THR), 1)) { mn = m_reg; alpha = 1.f; }
    else { mn = fmaxf(m_reg, pmax); alpha = __builtin_amdgcn_exp2f((m_reg - mn) * C2); m_reg = mn; }
    const float mnL = -mn * C2;
    for (int r = 0; r < 16; ++r) p0[r] = fmaf(p0[r], C2, mnL); for (int r = 0; r < 16; ++r) p1[r] = fmaf(p1[r], C2, mnL);
    for (int r = 0; r < 16; ++r) p0[r] = __builtin_amdgcn_exp2f(p0[r]);
}
__device__ __forceinline__ void finishSM(f32x16& p0, f32x16& p1, float alpha, float& l_reg, bf16x8& pa0, bf16x8& pa1, bf16x8& pa2, bf16x8& pa3) {
    for (int r = 0; r < 16; ++r) p1[r] = __builtin_amdgcn_exp2f(p1[r]);
    float ps = 0; for (int r = 0; r < 16; ++r) ps += p0[r]; for (int r = 0; r < 16; ++r) ps += p1[r];
    { auto rr = __builtin_amdgcn_permlane32_swap(__float_as_uint(ps), __float_as_uint(ps), false, false);
      ps = __uint_as_float(rr[0]) + __uint_as_float(rr[1]); }
    l_reg = l_reg * alpha + ps;
#define PK4(P, B_, OUT) do { unsigned a0 = cvtpk(P[B_+0], P[B_+1]), a1 = cvtpk(P[B_+2], P[B_+3]);                          \
        unsigned b0 = cvtpk(P[B_+4], P[B_+5]), b1 = cvtpk(P[B_+6], P[B_+7]);                                             \
        auto r0 = __builtin_amdgcn_permlane32_swap(a0, b0, false, false); auto r1 = __builtin_amdgcn_permlane32_swap(a1, b1, false, false); \
        u32x4 w = {r0[0], r1[0], r0[1], r1[1]}; OUT = *reinterpret_cast<bf16x8*>(&w); } while (0)
    PK4(p0, 0, pa0); PK4(p0, 8, pa1); PK4(p1, 0, pa2); PK4(p1, 8, pa3);
#undef PK4
}
template <int KB, bool SK>
__device__ __forceinline__ void qkt(f32x16& p0, f32x16& p1, const char* K_lds, int r32, int hi, const bf16x8* qr, bool act) {
    if (SK && !act) { const float NEG = -__builtin_inff();
#pragma unroll
        for (int r = 0; r < 16; ++r) { p0[r] = NEG; p1[r] = NEG; } return; }
    p0 = f32x16{}; p1 = f32x16{};
    const char* kb[4];
#pragma unroll
    for (int dd = 0; dd < 4; ++dd) kb[dd] = K_lds + KB * SHM_K + KSWZ(r32, (dd * 16 + hi * 8) * 2);
#pragma unroll
    for (int d0 = 0; d0 < 8; ++d0) { const char* a = kb[d0 & 3] + (d0 >> 2) * 128;
        bf16x8 b0 = *reinterpret_cast<const bf16x8*>(a);
        bf16x8 b1 = *reinterpret_cast<const bf16x8*>(a + 32 * 256);
        p0 = __builtin_amdgcn_mfma_f32_32x32x16_bf16(b0, qr[d0], p0, 0, 0, 0);
        p1 = __builtin_amdgcn_mfma_f32_32x32x16_bf16(b1, qr[d0], p1, 0, 0, 0); }
}
#define TRRD(dst, off) asm volatile("ds_read_b64_tr_b16 %0, %1 offset:%2" : "=&v"(dst) : "v"(vb0), "i"(off) : "memory")
#define PV_D0(VBv, d0, oo) do { s16x4 l0, l1, l2, l3, h0, h1, h2, h3; constexpr int b_ = (VBv) * att::SHM_V + att::v_rd_off(d0, 0, 0); \
        TRRD(l0, b_); TRRD(h0, b_ + 2048); TRRD(l1, b_ + 4096); TRRD(h1, b_ + 6144); TRRD(l2, b_ + 8192); TRRD(h2, b_ + 10240); TRRD(l3, b_ + 12288); TRRD(h3, b_ + 14336); \
        asm volatile("s_waitcnt lgkmcnt(0)" ::: "memory"); SBAR(); \
        oo = __builtin_amdgcn_mfma_f32_32x32x16_bf16(pa0, (bf16x8){l0[0], l0[1], l0[2], l0[3], h0[0], h0[1], h0[2], h0[3]}, oo, 0, 0, 0);   \
        oo = __builtin_amdgcn_mfma_f32_32x32x16_bf16(pa1, (bf16x8){l1[0], l1[1], l1[2], l1[3], h1[0], h1[1], h1[2], h1[3]}, oo, 0, 0, 0);   \
        oo = __builtin_amdgcn_mfma_f32_32x32x16_bf16(pa2, (bf16x8){l2[0], l2[1], l2[2], l2[3], h2[0], h2[1], h2[2], h2[3]}, oo, 0, 0, 0);   \
        oo = __builtin_amdgcn_mfma_f32_32x32x16_bf16(pa3, (bf16x8){l3[0], l3[1], l3[2], l3[3], h3[0], h3[1], h3[2], h3[3]}, oo, 0, 0, 0); } while (0)

struct BlockRef { int tok0, h, br, P0, dil; };
struct Bases { const bf16* Z; bf16* OB; float* LSE; };
#define BR_PIN(r) ((r).dil * ZP)
#define BR_ZB(r) (B.Z + (size_t)(r).tok0 * ZP + (r).h * HD)
#define BR_Q(r) (BR_ZB(r) + (size_t)(r).P0 * BR_PIN(r))
#define BR_K(r) (BR_ZB(r) + AW)
#define BR_V(r) (BR_ZB(r) + 2 * AW)
#define PVT_D0(VBv, d0, oo) do { s16x4 l0, l1, l2, l3, h0, h1, h2, h3; constexpr int b_ = (VBv) * att::SHM_V + att::v_rd_off(d0, 0, 0); \
        TRRD(l0, b_); TRRD(h0, b_ + 2048); TRRD(l1, b_ + 4096); TRRD(h1, b_ + 6144); TRRD(l2, b_ + 8192); TRRD(h2, b_ + 10240); TRRD(l3, b_ + 12288); TRRD(h3, b_ + 14336); \
        asm volatile("s_waitcnt lgkmcnt(0)" ::: "memory"); SBAR(); \
        oo = __builtin_amdgcn_mfma_f32_32x32x16_bf16((bf16x8){l0[0], l0[1], l0[2], l0[3], h0[0], h0[1], h0[2], h0[3]}, pa0, oo, 0, 0, 0);   \
        oo = __builtin_amdgcn_mfma_f32_32x32x16_bf16((bf16x8){l1[0], l1[1], l1[2], l1[3], h1[0], h1[1], h1[2], h1[3]}, pa1, oo, 0, 0, 0);   \
        oo = __builtin_amdgcn_mfma_f32_32x32x16_bf16((bf16x8){l2[0], l2[1], l2[2], l2[3], h2[0], h2[1], h2[2], h2[3]}, pa2, oo, 0, 0, 0);   \
        oo = __builtin_amdgcn_mfma_f32_32x32x16_bf16((bf16x8){l3[0], l3[1], l3[2], l3[3], h3[0], h3[1], h3[2], h3[3]}, pa3, oo, 0, 0, 0); } while (0)
template <int VB>
__device__ __forceinline__ void pvt_tile(f32x16* o, int vb0, bf16x8 pa0, bf16x8 pa1, bf16x8 pa2, bf16x8 pa3, bool act) {
    if (!act) return;
    PVT_D0(VB, 0, o[0]); PVT_D0(VB, 1, o[1]); PVT_D0(VB, 2, o[2]); PVT_D0(VB, 3, o[3]);
}
constexpr int QST_OFF = 2 * SHM_V + 3 * SHM_K;
__device__ __forceinline__ void swa_item(const BlockRef& cur, const BlockRef& nxt, const Bases& B, char* lds, LAS unsigned char* ldsl, const int tid, const bool first) {
    constexpr int W = 129;
    const int wid = __builtin_amdgcn_readfirstlane(tid >> 6), lane = tid & 63, r32 = lane & 31, hi = lane >> 5;
    const int kb0 = cur.P0 - 128;
    const int qlo = cur.P0 + wid * QBLK, qm = qlo + r32 - 4 * hi;
    char* K_lds = lds + 2 * SHM_V;
    const int vb0 = (int)(uintptr_t)lds + v_rd_base(lane);
    int kpk[2], vpk[2];
#pragma unroll
    for (int i = 0; i < 2; ++i) { const int c = 2 * wid + i;
        const int row = 4 * c + (lane >> 4), c16 = lane & 15; kpk[i] = row * 256 + ((c16 ^ (row & 7)) * 8);
        const int q = c * 64 + lane, sub = q >> 5, r = q & 31, kk = (sub >> 2) * 8 + (r >> 2), c8 = (sub & 3) * 4 + (r & 3), k = (kk & ~0xC) | ((kk & 4) << 1) | ((kk & 8) >> 1);
        vpk[i] = k * 256 + c8 * 8; }
    const unsigned kdst = (unsigned)(2 * SHM_V) + (unsigned)wid * 2048u, vdst = (unsigned)wid * 2048u, qdst = (unsigned)QST_OFF + (unsigned)wid * 8192u;
#define DMA_KX(ref, t) do { const int pin_ = BR_PIN(ref); const int kbc_ = (ref).P0 - 128 + 64 * (t); const bf16* g_ = BR_K(ref) + (long)(kbc_ < 0 ? 0 : kbc_) * pin_; _Pragma("unroll") for (int _i = 0; _i < 2; ++_i) \
        __builtin_amdgcn_global_load_lds((const unsigned*)(g_ + (unsigned)((kpk[_i] >> 8) * pin_ + (kpk[_i] & 255))), (LAS unsigned*)(ldsl + kdst + ((t) % 3) * SHM_K + _i * 1024), 16, 0, 0); } while (0)
#define DMA_VX(ref, t) do { const int pin_ = BR_PIN(ref); const int kbc_ = (ref).P0 - 128 + 64 * (t); const bf16* g_ = BR_V(ref) + (long)(kbc_ < 0 ? 0 : kbc_) * pin_; _Pragma("unroll") for (int _i = 0; _i < 2; ++_i) \
        __builtin_amdgcn_global_load_lds((const unsigned*)(g_ + (unsigned)((vpk[_i] >> 8) * pin_ + (vpk[_i] & 255))), (LAS unsigned*)(ldsl + vdst + ((t) % 2) * SHM_V + _i * 1024), 16, 0, 0); } while (0)
#define DMA_Q(ref) do { const int pin_ = BR_PIN(ref); const bf16* g_ = BR_Q(ref) + (size_t)(wid * QBLK) * pin_; _Pragma("unroll") for (int j_ = 0; j_ < 8; ++j_) { const int row_ = 4 * j_ + (lane >> 4); \
        __builtin_amdgcn_global_load_lds((const unsigned*)(g_ + (unsigned)(row_ * pin_ + (((lane & 15) ^ (row_ & 15)) * 8))), (LAS unsigned*)(ldsl + qdst + j_ * 1024), 16, 0, 0); } } while (0)
#define WAITV(n) asm volatile("s_waitcnt vmcnt(" #n ")" ::: "memory")
#define BARV(n) do { WAITV(n); __builtin_amdgcn_s_barrier(); asm volatile("" ::: "memory"); } while (0)
    if (first) { DMA_Q(cur); DMA_KX(cur, 0); DMA_VX(cur, 0); DMA_KX(cur, 1); WAITV(6); } else { WAITV(9); }
    bf16x8 qr[8];
#pragma unroll
    for (int d0 = 0; d0 < 8; ++d0) qr[d0] = *(const bf16x8*)(lds + qdst + r32 * 256 + (((2 * d0 + hi) ^ (r32 & 15)) << 4));
    asm volatile("s_waitcnt lgkmcnt(0)" ::: "memory");
    float m_reg = -1e30f, l_reg = 0; f32x16 o[4] = {};
#define RESC(a) do { if (__any((a) < 1.f)) { for (int d_ = 0; d_ < 4; ++d_) for (int r = 0; r < 16; ++r) o[d_][r] *= (a); } } while (0)
#define KBASE(t) (kb0 + 64 * (t))
#define ACT(t) (KBASE(t) >= 0 && KBASE(t) <= qlo + QBLK - 1 && KBASE(t) + KVBLK - 1 >= qlo - W + 1)
#define MASKT(P0_, P1_, t) do { const int kb_ = KBASE(t); if (kb_ + KVBLK - 1 > qlo || kb_ <= qlo + QBLK - 1 - W) mask_tile(P0_, P1_, qm - kb_, (unsigned)W); } while (0)
#define STEP(t, WAITS, ISSUE) do {                                                                                           \
        WAITS; ISSUE;                                                                                                        \
        if (ACT(t)) { f32x16 p0, p1; float mn, al; bf16x8 pa0, pa1, pa2, pa3;                                                \
            SBAR(); qkt<(t) % 3, false>(p0, p1, K_lds, r32, hi, qr, true);                                                  \
            MASKT(p0, p1, (t)); partialSM(p0, p1, m_reg, mn, al); RESC(al);                                                  \
            finishSM(p0, p1, al, l_reg, pa0, pa1, pa2, pa3); SBAR();                                                         \
            pvt_tile<(t) % 2>(o, vb0, pa0, pa1, pa2, pa3, true); } } while (0)
    STEP(0, do { if (first) BARV(2); else BARV(9); } while (0), do { DMA_VX(cur, 1); DMA_KX(cur, 2); } while (0));
    STEP(1, BARV(2), do { DMA_VX(cur, 2); DMA_KX(cur, 3); } while (0));
    STEP(2, BARV(2), do { DMA_VX(cur, 3); DMA_KX(cur, 4); } while (0));
    STEP(3, BARV(2), do { DMA_VX(cur, 4); DMA_KX(cur, 5); } while (0));
    STEP(4, BARV(2), do { DMA_VX(cur, 5); DMA_KX(nxt, 0); } while (0));
    STEP(5, BARV(2), do { DMA_VX(nxt, 0); DMA_KX(nxt, 1); DMA_Q(nxt); } while (0));
    const float inv = __builtin_amdgcn_rcpf(l_reg);
    const int pout = cur.dil * AW;
    char* Orow = (char*)(B.OB + ((size_t)cur.br * MTOK + cur.tok0) * AW + cur.h * HD + (size_t)(cur.P0 + wid * QBLK + r32) * pout) + hi * 16;
#pragma unroll
    for (int d0 = 0; d0 < 4; ++d0)
#pragma unroll
        for (int pr = 0; pr < 2; ++pr) {
            unsigned ax = cvtpk(o[d0][8 * pr + 0] * inv, o[d0][8 * pr + 1] * inv), ay = cvtpk(o[d0][8 * pr + 2] * inv, o[d0][8 * pr + 3] * inv);
            unsigned bx = cvtpk(o[d0][8 * pr + 4] * inv, o[d0][8 * pr + 5] * inv), by = cvtpk(o[d0][8 * pr + 6] * inv, o[d0][8 * pr + 7] * inv);
            auto rx = __builtin_amdgcn_permlane32_swap(ax, bx, false, false); auto ry = __builtin_amdgcn_permlane32_swap(ay, by, false, false);
            u32x4 w = {rx[0], ry[0], rx[1], ry[1]};
            *(u32x4*)(Orow + 16 * (4 * d0 + 2 * pr)) = w; }
    if (hi == 0) B.LSE[((size_t)cur.br * MTOK + cur.tok0) * NAH + cur.h + (size_t)(cur.P0 + wid * QBLK + r32) * (cur.dil * NAH)] = m_reg * SCALE + __builtin_amdgcn_logf(l_reg) * 0.6931471805599453f;
#undef RESC
#undef KBASE
#undef ACT
#undef MASKT
#undef STEP
#undef DMA_KX
#undef DMA_VX
#undef DMA_Q
#undef WAITV
#undef BARV
}
}

constexpr int NWAVES = 8;
constexpr size_t MiB = 1u << 20;
constexpr size_t WS_CTL = 0, CTL_ZERO_BYTES = 3 * MiB + 512 * 1024;
constexpr size_t WS_SSQ = 1 * MiB;
constexpr size_t WS_BIASR = 2 * MiB + 256 * 1024;
constexpr size_t WS_MODV = 8 * MiB;
constexpr size_t WS_ROPE = 9 * MiB;
constexpr size_t WS_SGUW = 13 * MiB;
constexpr size_t WS_LSE = 14 * MiB;
constexpr size_t WS_PART = 20 * MiB;
constexpr size_t WS_W = 44 * MiB;
constexpr size_t SZ_WINE = (size_t)MIXIN * DM * 2, SZ_WSQ = (size_t)DM * DM * 2, SZ_WINO = (size_t)CIN * DM * 2, SZ_WGU = (size_t)NGU * DM * 2, SZ_WD = (size_t)DM * DFF * 2;
constexpr size_t WS_WINE = WS_W, WS_WOUTE = WS_WINE + 2 * SZ_WINE, WS_WINO = WS_WOUTE + 2 * SZ_WSQ, WS_WOUTO = WS_WINO + 2 * SZ_WINO, WS_WGU = WS_WOUTO + 2 * SZ_WSQ, WS_WD = WS_WGU + 4 * SZ_WGU;
constexpr size_t WS_H = 432 * MiB;
constexpr size_t WS_Z = 560 * MiB;
constexpr size_t WS_AO = 944 * MiB;
constexpr size_t WS_OB = 1072 * MiB;
constexpr size_t WS_XB = 1360 * MiB;
constexpr size_t WS_END = 1488 * MiB;
constexpr size_t BIAS_INE = 0, BIAS_INO = BIAS_INE + 2 * 4 * MIXIN, BIAS_GU = BIAS_INO + 2 * 4 * CIN, BIAS_END = BIAS_GU + 4 * 4 * NGU;
static_assert(WS_SSQ + 9 * (size_t)MTOK * sizeof(u64) <= WS_BIASR && WS_BIASR + BIAS_END * sizeof(i64) <= CTL_ZERO_BYTES, "zeroed region");
static_assert(WS_WD + 4 * SZ_WD <= WS_H, "weights fit");
constexpr int CW_TMO = 0, CW_BAR = 4096;
constexpr int RING_OFF = 0, RING_BYTES = 131072;
constexpr int LDSCTL_OFF = 147456, MISC_OFF = LDSCTL_OFF + 320;
constexpr int LDS_BYTES = 155648;

typedef GAS unsigned gu32;
#define RLX_AGENT __ATOMIC_RELAXED, __HIP_MEMORY_SCOPE_AGENT
#define LDS_WAIT() asm volatile("s_waitcnt lgkmcnt(0)" ::: "memory")
#define VM_WAIT() asm volatile("s_waitcnt vmcnt(0)" ::: "memory")

#define XB_TMO      128
#define XB_XCNT(j)  (256  + 64 * (j))
#define XB_XSUB(j)  (1280 + 64 * (j))
#define XB_XGEN(j)  (2304 + 64 * (j))
#define XB_TOP      3328
#define XB_TOPGEN   3392
#define XCD_BAR_WORDS 3456
#define XB_SPIN_CAP (1u << 18)
__device__ __forceinline__ unsigned xb_ld(unsigned* p)              { return __hip_atomic_load(p, __ATOMIC_RELAXED, __HIP_MEMORY_SCOPE_AGENT); }
__device__ __forceinline__ unsigned xb_add(unsigned* p, unsigned v) { return __hip_atomic_fetch_add(p, v, __ATOMIC_RELAXED, __HIP_MEMORY_SCOPE_AGENT); }
__device__ __forceinline__ unsigned xb_xcc_id() { return (unsigned)__builtin_amdgcn_s_getreg((3 << 11) | 20) & 0xFu; }
#define XB_SPIN(cond, bar) do { unsigned _sp = 0; while (cond) { __builtin_amdgcn_s_sleep(1); \
    if ((++_sp & 255u) == 0u) { if (xb_ld(&(bar)[XB_TMO])) break; if (_sp > XB_SPIN_CAP) { atomicAdd(&(bar)[XB_TMO], 1u); break; } } } } while (0)
struct XcdBarrier { unsigned* bar; unsigned x; volatile LAS unsigned* st; };
__device__ __forceinline__ XcdBarrier xcd_barrier_post(unsigned* bar, volatile LAS unsigned* st) {
    XcdBarrier b; b.bar = bar; b.x = xb_xcc_id(); b.st = st;
    if (threadIdx.x == 0) (void)xb_add(&bar[XB_XCNT(b.x)], 1u);
    return b;
}
__device__ __forceinline__ void xcd_barrier_complete(unsigned* bar, unsigned x, unsigned& nloc, unsigned& nx) {
    const unsigned G = gridDim.x * gridDim.y * gridDim.z;
    unsigned sum, cnt, mine, sp = 0u;
    for (;;) {
        sum = 0u; cnt = 0u; mine = 0u;
#pragma unroll
        for (unsigned j = 0; j < 16; ++j) { const unsigned c = xb_ld(&bar[XB_XCNT(j)]); sum += c; cnt += (c > 0u) ? 1u : 0u; mine = (j == x) ? c : mine; }
        if (sum == G) break;
        __builtin_amdgcn_s_sleep(1);
        if ((++sp & 255u) == 0u) { if (xb_ld(&bar[XB_TMO])) break; if (sp > XB_SPIN_CAP) { atomicAdd(&bar[XB_TMO], 1u); break; } }
    }
    nloc = mine > 0u ? mine : 1u; nx = cnt > 0u ? cnt : 1u;
}
__device__ __forceinline__ void xcd_barrier(const XcdBarrier& b) {
    asm volatile("s_waitcnt vmcnt(0)" ::: "memory");
    __syncthreads();
    if (threadIdx.x == 0) {
        unsigned* bar = b.bar;
        __builtin_amdgcn_s_waitcnt(0);
        unsigned nloc = b.st[0], nx = b.st[1];
        if (nloc == 0u) { xcd_barrier_complete(bar, b.x, nloc, nx); b.st[0] = nloc; b.st[1] = nx; }
        const unsigned old = xb_add(&bar[XB_XSUB(b.x)], 1u);
        const unsigned gen = old / nloc;
        if (old + 1u == (gen + 1u) * nloc) {
            __builtin_amdgcn_fence(__ATOMIC_RELEASE, "agent");
            asm volatile("s_waitcnt vmcnt(0)" ::: "memory");
            const unsigned og = xb_add(&bar[XB_TOP], 1u);
            const unsigned tg = og / nx;
            if (og + 1u == (tg + 1u) * nx) xb_add(&bar[XB_TOPGEN], 1u);
            else XB_SPIN(xb_ld(&bar[XB_TOPGEN]) == tg, bar);
            __builtin_amdgcn_fence(__ATOMIC_ACQUIRE, "agent");
            xb_add(&bar[XB_XGEN(b.x)], 1u);
            asm volatile("s_waitcnt vmcnt(0)" ::: "memory");
        } else {
            XB_SPIN(xb_ld(&bar[XB_XGEN(b.x)]) == gen, bar);
            __builtin_amdgcn_fence(__ATOMIC_ACQUIRE, "agent");
            asm volatile("s_waitcnt vmcnt(0)" ::: "memory");
        }
    }
    __syncthreads();
}

struct Args { const void* in[18]; float* out; unsigned char* ws; int ph_lo, ph_hi, dry, pad; };
enum { I_X = 0, I_C, I_POS, I_ADAW, I_ADAB, I_NMIX, I_NFFN, I_ABWIN, I_SGUW, I_SGUB, I_ABWOUT, I_CWIN, I_CW, I_CWOUT, I_FG, I_FU, I_FD, I_FNORM };

__device__ __forceinline__ float wave_sum(float v) {
    v += swz_xor<1>(v); v += swz_xor<2>(v); v += swz_xor<4>(v); v += swz_xor<8>(v); v += swz_xor<16>(v);
    auto rr = __builtin_amdgcn_permlane32_swap(__float_as_uint(v), __float_as_uint(v), false, false);
    return __uint_as_float(rr[0]) + __uint_as_float(rr[1]);
}
__device__ __forceinline__ unsigned pk2(float lo, float hi) { return cvt_pk_bf16(lo, hi); }

__device__ __forceinline__ void p0_transpose_item(const float* W, int ldn, int col0, int k0, bf16* WT, int K, int drow0, bool perm, LAS float* scr, int lane, const float* shv, i64* biasr, int bN) {
    float wv[32];
#pragma unroll
    for (int i = 0; i < 32; ++i) { const int kk = 2 * i + (lane >> 5); wv[i] = W[(size_t)(k0 + kk) * ldn + col0 + (lane & 31)]; }
#pragma unroll
    for (int i = 0; i < 32; ++i) { const int kk = 2 * i + (lane >> 5); scr[kk * 33 + (lane & 31)] = wv[i]; }
    if (biasr) {
        LAS float* scs = scr + 64 * 33;
#pragma unroll
        for (int b = 0; b < 4; ++b) scs[b * 64 + lane] = shv[(size_t)b * 6 * DM + k0 + lane];
    }
    LDS_WAIT(); asm volatile("" ::: "memory");
    if (biasr) {
        const LAS float* scs = scr + 64 * 33;
        const int rho = lane & 31, kh = lane >> 5, src = perm ? pg8::perm32(rho) : rho;
        float a0 = 0.f, a1 = 0.f, a2 = 0.f, a3 = 0.f;
#pragma unroll 8
        for (int k2 = 0; k2 < 32; ++k2) { const int kk = 32 * kh + k2; const float w = scr[kk * 33 + src];
            a0 += w * scs[kk]; a1 += w * scs[64 + kk]; a2 += w * scs[128 + kk]; a3 += w * scs[192 + kk]; }
        a0 = half_sum(a0); a1 = half_sum(a1); a2 = half_sum(a2); a3 = half_sum(a3);
        if (lane < 32) { i64* bp = biasr + rho;
            __hip_atomic_fetch_add(bp, (i64)(a0 * BIAS_SCALE), __ATOMIC_RELAXED, __HIP_MEMORY_SCOPE_AGENT); __hip_atomic_fetch_add(bp + bN, (i64)(a1 * BIAS_SCALE), __ATOMIC_RELAXED, __HIP_MEMORY_SCOPE_AGENT);
            __hip_atomic_fetch_add(bp + 2 * bN, (i64)(a2 * BIAS_SCALE), __ATOMIC_RELAXED, __HIP_MEMORY_SCOPE_AGENT); __hip_atomic_fetch_add(bp + 3 * bN, (i64)(a3 * BIAS_SCALE), __ATOMIC_RELAXED, __HIP_MEMORY_SCOPE_AGENT); }
    }
    const int c = lane & 7;
#pragma unroll
    for (int j = 0; j < 4; ++j) { const int rho = (lane >> 3) + 8 * j; const int src = perm ? pg8::perm32(rho) : rho; const LAS float* s = scr + (8 * c) * 33 + src;
        u32x4 o; o.x = pk2(s[0 * 33], s[1 * 33]); o.y = pk2(s[2 * 33], s[3 * 33]); o.z = pk2(s[4 * 33], s[5 * 33]); o.w = pk2(s[6 * 33], s[7 * 33]);
        *(GAS u32x4*)(WT + (size_t)(drow0 + rho) * K + k0 + 8 * c) = o; }
    LDS_WAIT(); asm volatile("" ::: "memory");
}

__device__ __forceinline__ void prenorm_rows(int gw, int lane, const float* xin, bf16* XB, bf16* outp, const float* A, int bstride, u64* ssq) {
    const int r0 = gw * 16, b = r0 / SEQ;
    f32x4 av[8];
#pragma unroll
    for (int j = 0; j < 8; ++j) av[j] = *(const f32x4*)(A + (size_t)b * bstride + 4 * (lane + 64 * j));
    for (int r = 0; r < 16; ++r) { const size_t row = (size_t)(r0 + r);
        const f32x4* xr = (const f32x4*)(xin + row * DM) + lane;
        f32x4 v[8]; float ss = 0.f;
#pragma unroll
        for (int j = 0; j < 8; ++j) v[j] = xr[64 * j];
#pragma unroll
        for (int j = 0; j < 8; ++j) { u32x2 w; w.x = pk2(v[j].x, v[j].y); w.y = pk2(v[j].z, v[j].w); *((u32x2*)(XB + row * DM) + lane + 64 * j) = w;
            v[j] = (f32x4){bf_lo(w.x), bf_hi(w.x), bf_lo(w.y), bf_hi(w.y)}; ss += (v[j].x * v[j].x + v[j].y * v[j].y) + (v[j].z * v[j].z + v[j].w * v[j].w); }
        ss = wave_sum(ss);
        if (lane == 0) ssq[row] = (u64)(ss * SSQ_SCALE + 0.5f);
#pragma unroll
        for (int j = 0; j < 8; ++j) { const f32x4 o = v[j] * av[j]; u32x2 w; w.x = pk2(o.x, o.y); w.y = pk2(o.z, o.w); *((u32x2*)(outp + row * DM) + lane + 64 * j) = w; }
    }
}
__device__ __forceinline__ void final_rows(int gw, int lane, const bf16* XB, float* outp, const float* A, const u64* ssq) {
    f32x4 av[4][2];
#pragma unroll
    for (int j = 0; j < 4; ++j) { av[j][0] = *(const f32x4*)(A + 8 * (lane + 64 * j)); av[j][1] = *(const f32x4*)(A + 8 * (lane + 64 * j) + 4); }
    for (int rb = 0; rb < 16; rb += 4) {
        u32x4 xq[4][4]; u64 sq[4];
#pragma unroll
        for (int r = 0; r < 4; ++r) { const size_t row = (size_t)gw * 16 + rb + r; sq[r] = ssq[row];
#pragma unroll
            for (int j = 0; j < 4; ++j) xq[r][j] = *((const u32x4*)(XB + row * DM) + lane + 64 * j); }
#pragma unroll
        for (int r = 0; r < 4; ++r) { const size_t row = (size_t)gw * 16 + rb + r; const float rstd = 1.0f / sqrtf((float)sq[r] * (1.0f / (SSQ_SCALE * DM)) + EPS);
#pragma unroll
            for (int j = 0; j < 4; ++j) { const u32x4 xi = xq[r][j];
                float* op = outp + row * DM + 8 * (lane + 64 * j);
                *(f32x4*)op = (f32x4){bf_lo(xi.x), bf_hi(xi.x), bf_lo(xi.y), bf_hi(xi.y)} * rstd * av[j][0];
                *(f32x4*)(op + 4) = (f32x4){bf_lo(xi.z), bf_hi(xi.z), bf_lo(xi.w), bf_hi(xi.w)} * rstd * av[j][1]; } }
    }
}


typedef __attribute__((address_space(4))) const char kargc;
__device__ __forceinline__ const void* karg(int idx) {
    asm volatile("" : "+s"(idx));
    kargc* kp = (kargc*)__builtin_amdgcn_kernarg_segment_ptr();
    return *(const void* __attribute__((address_space(4))) const*)(kp + (size_t)idx * 8);
}
#define KIN(i) karg(i)
#define KOUT() ((float*)karg(18))
#define KWS() ((unsigned char*)karg(19))

__device__ __forceinline__ att::BlockRef att_mkref(int L, int G) {
    const int rnd = L / G, w = L - rnd * G; const int xx = (w + rnd) & 31; const int bh = (rnd / 3) * 8 + (w >> 5), br = rnd % 3;
    const int dsh = 2 * br, nqb = 32 >> dsh;
    const int rr = xx / nqb, qb = xx % nqb, b = bh / NAH, h = bh % NAH;
    att::BlockRef R; R.tok0 = b * SEQ + rr; R.h = h; R.br = br; R.P0 = qb * att::QB; R.dil = 1 << dsh;
    return R;
}

__global__ void __launch_bounds__(NWAVES * 64, 2) mega_fwd(Args args) {
    extern __shared__ __attribute__((aligned(16))) unsigned char lds[];
    LAS unsigned char* ldsl = (LAS unsigned char*)lds;
    volatile LAS unsigned* MISC = (volatile LAS unsigned*)(ldsl + MISC_OFF);
    const int tid0 = threadIdx.x, wave = __builtin_amdgcn_readfirstlane(tid0 >> 6);
#define OPAQUE_TID() int tid = threadIdx.x; asm volatile("" : "+v"(tid)); const int lane = tid & 63; (void)lane
    const int G = gridDim.x; const int bx = blockIdx.x; const int vcu = (G % 8 == 0) ? (bx % 8) * (G / 8) + bx / 8 : bx;
    const int gw = vcu * NWAVES + wave, NGW = G * NWAVES;
    gu32* ctl = (gu32*)(args.ws + WS_CTL);
    for (int u = tid0; u < (LDS_BYTES - LDSCTL_OFF) / 4; u += NWAVES * 64) ((LAS unsigned*)(ldsl + LDSCTL_OFF))[u] = 0u;
    __syncthreads();
    XcdBarrier bar; bar.bar = (unsigned*)(ctl + CW_BAR); bar.x = 0; bar.st = nullptr;
    if (!MK_PER_PHASE) bar = xcd_barrier_post((unsigned*)(ctl + CW_BAR), MISC + 8);
    const int lo = args.ph_lo, hi = args.ph_hi;
#define IN(k) (lo <= (k) && (k) < hi)
#define SEAM(k) do { if (!MK_PER_PHASE && (k) + 1 < hi) xcd_barrier(bar); } while (0)

    if (IN(0)) { OPAQUE_TID(); unsigned char* ws = KWS(); float* PART = (float*)(ws + WS_PART);
        { const float* cin = (const float*)KIN(I_C); const float* adaw = (const float*)KIN(I_ADAW);
          for (int it = gw; it < 4 * 32 * 48; it += NGW) { const int ng = it % 48, kc = (it / 48) % 32, l = it / (48 * 32);
              const int k0 = 64 * kc, n0 = 256 * ng;
              float ca[4];
#pragma unroll
              for (int b = 0; b < 4; ++b) ca[b] = silu_f(cin[b * DM + k0 + lane]);
              f32x4 ac[4];
#pragma unroll
              for (int b = 0; b < 4; ++b) ac[b] = (f32x4){0.f, 0.f, 0.f, 0.f};
              const float* wp = adaw + ((size_t)l * DM + k0) * (6 * DM) + n0 + 4 * lane;
#pragma unroll 16
              for (int kk = 0; kk < 64; ++kk) { const f32x4 w = *(const f32x4*)(wp + (size_t)kk * (6 * DM));
#pragma unroll
                  for (int b = 0; b < 4; ++b) { const float s = __uint_as_float(__builtin_amdgcn_readlane(__float_as_uint(ca[b]), kk)); ac[b] += w * s; } }
#pragma unroll
              for (int b = 0; b < 4; ++b) *(f32x4*)(PART + ((size_t)((kc * 4 + l) * 4 + b)) * (6 * DM) + n0 + 4 * lane) = ac[b];
          } }
        { const int* pos = (const int*)KIN(I_POS); float* ROPE = (float*)(ws + WS_ROPE);
          for (int e = vcu * 512 + tid; e < MTOK * 16; e += G * 512) { const int row = e >> 4, i = e & 15;
              const double invf = exp2(-(double)i * (18.931568569324174 / 16.0));
              const double rev = (double)pos[row] * invf * 0.15915494309189535;
              const float fr = (float)(rev - floor(rev));
              ROPE[(size_t)row * 32 + i] = __builtin_amdgcn_cosf(fr); ROPE[(size_t)row * 32 + 16 + i] = __builtin_amdgcn_sinf(fr); } }
        { const float* sw = (const float*)KIN(I_SGUW); bf16* SGUW = (bf16*)(ws + WS_SGUW);
          for (int e = vcu * 512 + tid; e < 2 * 4 * 128 * 128; e += G * 512) { const int s = e & 127, t = (e >> 7) & 127;
              SGUW[e] = (bf16)(cvt_pk_bf16(s <= t ? sw[e] : 0.f, 0.f) & 0xffffu); } }
    }
    SEAM(0);
    if (IN(1)) { OPAQUE_TID(); unsigned char* ws = KWS(); float* PART = (float*)(ws + WS_PART); float* MODV = (float*)(ws + WS_MODV);
        const float* adab = (const float*)KIN(I_ADAB); const float* nmix = (const float*)KIN(I_NMIX); const float* nffn = (const float*)KIN(I_NFFN);
        for (int e = vcu * 512 + tid; e < 6 * 4 * 4 * DM; e += G * 512) { const int col = e % DM, b = (e / DM) % 4, l = (e / (4 * DM)) % 4, ch = e / (16 * DM);
            float pv[32];
#pragma unroll
            for (int kc = 0; kc < 32; ++kc) pv[kc] = PART[((size_t)((kc * 4 + l) * 4 + b)) * (6 * DM) + ch * DM + col];
            float sm = adab[l * 6 * DM + ch * DM + col];
#pragma unroll
            for (int kc = 0; kc < 32; ++kc) sm += pv[kc];
            const int slot = (ch == 0) ? 1 : (ch == 1) ? 0 : (ch == 3) ? 4 : (ch == 4) ? 3 : ch;
            float val = sm;
            if (ch == 1) val = nmix[l * DM + col] * (1.0f + sm);
            if (ch == 4) val = nffn[l * DM + col] * (1.0f + sm);
            MODV[((size_t)(l * 4 + b) * 6 + slot) * DM + col] = val; }
    }
    SEAM(1);
    if (IN(2)) { OPAQUE_TID(); unsigned char* ws = KWS(); const float* MODVc = (const float*)(ws + WS_MODV); i64* BIASR = (i64*)(ws + WS_BIASR);
        { LAS float* scr = (LAS float*)(ldsl + RING_OFF + wave * 16384);
          constexpr int C0 = 2 * 176 * 32, C1 = 2 * 64 * 32, C2 = 2 * 192 * 32, C3 = 2 * 64 * 32, C4 = 4 * 352 * 32, C5 = 4 * 64 * 88;
          constexpr int NIT = C0 + C1 + C2 + C3 + C4 + C5;
          for (int it = gw; it < NIT; it += NGW) { int r = it;
              if (r < C0) { const int i = r / (176 * 32), rem = r % (176 * 32), kb = rem / 176, gd = rem % 176;
                  p0_transpose_item((const float*)KIN(I_ABWIN) + (size_t)i * DM * MIXIN, MIXIN, 32 * gd, 64 * kb, (bf16*)(ws + WS_WINE + i * SZ_WINE), DM, 32 * gd, gd >= 96, scr, lane, MODVc + ((size_t)(2 * i) * 4 * 6 + 1) * DM, BIASR + BIAS_INE + (size_t)i * 4 * MIXIN + 32 * gd, MIXIN); continue; } r -= C0;
              if (r < C1) { const int i = r / (64 * 32), rem = r % (64 * 32), kb = rem / 64, gd = rem % 64;
                  p0_transpose_item((const float*)KIN(I_ABWOUT) + (size_t)i * DM * DM, DM, 32 * gd, 64 * kb, (bf16*)(ws + WS_WOUTE + i * SZ_WSQ), DM, 32 * gd, true, scr, lane, nullptr, nullptr, 0); continue; } r -= C1;
              if (r < C2) { const int i = r / (192 * 32), rem = r % (192 * 32), kb = rem / 192, gd = rem % 192; const int t = gd >> 3, w = gd & 7;
                  const int col0 = (t < 8) ? 32 * gd : ((w < 4) ? 2048 + 128 * (t - 8) + 32 * w : 4096 + 128 * (t - 8) + 32 * (w - 4));
                  p0_transpose_item((const float*)KIN(I_CWIN) + (size_t)i * DM * CIN, CIN, col0, 64 * kb, (bf16*)(ws + WS_WINO + i * SZ_WINO), DM, 32 * gd, true, scr, lane, MODVc + ((size_t)(2 * i + 1) * 4 * 6 + 1) * DM, BIASR + BIAS_INO + (size_t)i * 4 * CIN + 32 * gd, CIN); continue; } r -= C2;
              if (r < C3) { const int i = r / (64 * 32), rem = r % (64 * 32), kb = rem / 64, gd = rem % 64;
                  p0_transpose_item((const float*)KIN(I_CWOUT) + (size_t)i * DM * DM, DM, 32 * gd, 64 * kb, (bf16*)(ws + WS_WOUTO + i * SZ_WSQ), DM, 32 * gd, true, scr, lane, nullptr, nullptr, 0); continue; } r -= C3;
              if (r < C4) { const int l = r / (352 * 32), rem = r % (352 * 32), kb = rem / 352, gd = rem % 352; const int t = gd >> 3, w = gd & 7;
                  const float* src = (const float*)KIN((w < 4) ? I_FG : I_FU);
                  p0_transpose_item(src + (size_t)l * DM * DFF, DFF, 128 * t + 32 * (w & 3), 64 * kb, (bf16*)(ws + WS_WGU + l * SZ_WGU), DM, 32 * gd, true, scr, lane, MODVc + ((size_t)l * 4 * 6 + 4) * DM, BIASR + BIAS_GU + (size_t)l * 4 * NGU + 32 * gd, NGU); continue; } r -= C4;
              { const int l = r / (64 * 88), rem = r % (64 * 88), kb = rem / 64, gd = rem % 64;
                  p0_transpose_item((const float*)KIN(I_FD) + (size_t)l * DFF * DM, DM, 32 * gd, 64 * kb, (bf16*)(ws + WS_WD + l * SZ_WD), DFF, 32 * gd, true, scr, lane, nullptr, nullptr, 0); }
          } }
        prenorm_rows(gw, lane, (const float*)KIN(I_X), (bf16*)(ws + WS_XB), (bf16*)(ws + WS_H), MODVc, 6 * DM, (u64*)(ws + WS_SSQ) + (size_t)8 * MTOK);
    }
    SEAM(2);

    for (int layer = 0; layer < 4; ++layer) {
        const int pb = 3 + 8 * layer, li = layer >> 1; const bool even_layer = (layer & 1) == 0;
#define PH_SETUP() OPAQUE_TID(); unsigned char* ws = KWS(); const float* mv = (const float*)(ws + WS_MODV) + (size_t)layer * 4 * 6 * DM; (void)mv
        if (IN(pb + 1)) { PH_SETUP(); bf16* Hb = (bf16*)(ws + WS_H); bf16* Zb = (bf16*)(ws + WS_Z);
            if (even_layer) {
                pg8::Gemm g{Hb, (const bf16*)(ws + WS_WINE + li * SZ_WINE), MTOK, MIXIN, DM}; pg8::StaticOrder S; S.init(MTOK, MIXIN, G, bx);
                pg8::EpiInE E{Zb, (const float*)(ws + WS_ROPE), NormIn{(const u64*)(ws + WS_SSQ) + (size_t)(layer == 0 ? 8 : 2 * layer - 1) * MTOK, (const i64*)(ws + WS_BIASR) + BIAS_INE + (size_t)li * 4 * MIXIN, MIXIN, ldsl + LDSCTL_OFF + 1024}};
                pg8::gemm_phase<pg8::EpiInE, pg8::StaticOrder, true, true>(ldsl + RING_OFF, g, S, E, tid);
            } else {
                pg8::Gemm g{Hb, (const bf16*)(ws + WS_WINO + li * SZ_WINO), MTOK, CIN, DM}; pg8::StaticOrder S; S.init(MTOK, CIN, G, bx);
                pg8::EpiInO E{Zb, Zb + (size_t)MTOK * DM, NormIn{(const u64*)(ws + WS_SSQ) + (size_t)(2 * layer - 1) * MTOK, (const i64*)(ws + WS_BIASR) + BIAS_INO + (size_t)li * 4 * CIN, CIN, ldsl + LDSCTL_OFF + 1024}};
                pg8::gemm_phase<pg8::EpiInO, pg8::StaticOrder, true, true>(ldsl + RING_OFF, g, S, E, tid);
            }
        }
        SEAM(pb + 1);
        if (IN(pb + 2)) { PH_SETUP(); bf16* Zb = (bf16*)(ws + WS_Z); bf16* AO = (bf16*)(ws + WS_AO);
            if (even_layer) {
                {   constexpr int NITEM = 3 * 48 * 32; bf16* OB = (bf16*)(ws + WS_OB); float* LSE = (float*)(ws + WS_LSE);
                    const att::Bases BS{Zb, OB, LSE};
                    if (vcu < NITEM) { att::BlockRef cur = att_mkref(vcu, G); bool first = true;
                        for (int L = vcu; L < NITEM; L += G) { const att::BlockRef nxt = (L + G < NITEM) ? att_mkref(L + G, G) : cur;
                            att::swa_item(cur, nxt, BS, (char*)lds + RING_OFF, ldsl + RING_OFF, tid, first); cur = nxt; first = false; } }
                }
                VM_WAIT(); __syncthreads();
                {   const bf16* sgw = (const bf16*)(ws + WS_SGUW) + (size_t)li * 4 * 128 * 128; const float* sgb = (const float*)KIN(I_SGUB) + (size_t)li * 4 * 128;
                    char* V_lds = (char*)lds + RING_OFF;
                    int tid2 = threadIdx.x; asm volatile("" : "+v"(tid2)); const int lane2 = tid2 & 63;
                    const int r32 = lane2 & 31, hi2 = lane2 >> 5, sr = tid2 >> 4, sc = (tid2 & 15) * 8;
                    for (int s = vcu; s < 4 * 64 * 4; s += G) { const int g = s & 3, n = (s >> 2) & 63, b = s >> 8;
                        const size_t row0 = (size_t)b * SEQ + n * 128;
                        const int tb = (wave & 3) * 32, ch = wave >> 2;
                        bf16x8 vst[4];
#pragma unroll
                        for (int p = 0; p < 4; ++p) vst[p] = att::ld8(Zb + (row0 + 32 * p + sr) * ZP + 5120 + g * 128 + sc);
                        const bf16* wrow = sgw + ((size_t)g * 128 + tb + r32) * 128 + 8 * hi2;
                        bf16x8 wa[8];
#pragma unroll
                        for (int i = 0; i < 8; ++i) wa[i] = att::ld8(wrow + 16 * i);
                        const size_t rowt = row0 + tb + r32;
                        const bf16* up = Zb + rowt * ZP + 4608 + g * 128 + ch * 64 + 4 * hi2;
                        u32x2 uv[2][4];
#pragma unroll
                        for (int e = 0; e < 2; ++e)
#pragma unroll
                            for (int rg = 0; rg < 4; ++rg) uv[e][rg] = *(const u32x2*)(up + e * 32 + 8 * rg);
                        const float bias = sgb[g * 128 + tb + r32];
#pragma unroll
                        for (int p = 0; p < 4; ++p) { const int k = 32 * p + sr; *(bf16x8*)(V_lds + (k >> 6) * att::SHM_V + att::v_st(k & 63, sc)) = vst[p]; }
                        __syncthreads();
                        f32x16 o0 = {}, o1 = {};
                        const int vb0 = (int)(uintptr_t)V_lds + att::v_rd_base(lane2) + ch * 1024;
                        { bf16x8 pa0 = wa[0], pa1 = wa[1], pa2 = wa[2], pa3 = wa[3];
                          PVT_D0(0, 0, o0); PVT_D0(0, 1, o1); }
                        if (tb >= 64) { bf16x8 pa0 = wa[4], pa1 = wa[5], pa2 = wa[6], pa3 = wa[7];
                          PVT_D0(1, 0, o0); PVT_D0(1, 1, o1); }
                        bf16* op = AO + rowt * DM + AW + g * 128 + ch * 64 + 4 * hi2;
#pragma unroll
                        for (int e = 0; e < 2; ++e)
#pragma unroll
                            for (int rg = 0; rg < 4; ++rg) { const u32x2 u2 = uv[e][rg]; float m4[4];
#pragma unroll
                                for (int j = 0; j < 4; ++j) m4[j] = (e ? o1[4 * rg + j] : o0[4 * rg + j]) + bias;
                                u32x2 w; w.x = cvt_pk_bf16(bf_lo(u2.x) * m4[0], bf_hi(u2.x) * m4[1]); w.y = cvt_pk_bf16(bf_lo(u2.y) * m4[2], bf_hi(u2.y) * m4[3]);
                                *(u32x2*)(op + e * 32 + 8 * rg) = w; }
                        __syncthreads();
                    }
                }
            } else {
                const bf16* GBp = Zb; const bf16* Yp = Zb + (size_t)MTOK * DM; const float* cw = (const float*)KIN(I_CW) + (size_t)li * 3 * DM;
                const int r0 = gw * 16; const bool first = (r0 % SEQ) == 0;
                for (int cc = 0; cc < 4; ++cc) { const int col = 512 * cc + 8 * lane;
                    float w0[8], w1[8], w2[8], ym2[8], ym1[8];
#pragma unroll
                    for (int j = 0; j < 8; ++j) { w0[j] = cw[col + j]; w1[j] = cw[DM + col + j]; w2[j] = cw[2 * DM + col + j]; ym2[j] = 0.f; ym1[j] = 0.f; }
                    if (!first) { const u32x4 a = *(const u32x4*)(Yp + (size_t)(r0 - 2) * DM + col), c = *(const u32x4*)(Yp + (size_t)(r0 - 1) * DM + col);
#pragma unroll
                        for (int q = 0; q < 4; ++q) { ym2[2 * q] = bf_lo(a[q]); ym2[2 * q + 1] = bf_hi(a[q]); ym1[2 * q] = bf_lo(c[q]); ym1[2 * q + 1] = bf_hi(c[q]); } }
                    for (int rb = 0; rb < 16; rb += 8) {
                      u32x4 yq[8], gq[8];
#pragma unroll
                      for (int r = 0; r < 8; ++r) { const size_t off = (size_t)(r0 + rb + r) * DM + col; yq[r] = *(const u32x4*)(Yp + off); gq[r] = *(const u32x4*)(GBp + off); }
#pragma unroll
                      for (int r = 0; r < 8; ++r) { const size_t off = (size_t)(r0 + rb + r) * DM + col;
                        const u32x4 yv = yq[r], gv = gq[r];
                        float y0[8], gb[8], o[8];
#pragma unroll
                        for (int q = 0; q < 4; ++q) { y0[2 * q] = bf_lo(yv[q]); y0[2 * q + 1] = bf_hi(yv[q]); gb[2 * q] = bf_lo(gv[q]); gb[2 * q + 1] = bf_hi(gv[q]); }
#pragma unroll
                        for (int j = 0; j < 8; ++j) { o[j] = gb[j] * (w0[j] * ym2[j] + w1[j] * ym1[j] + w2[j] * y0[j]); ym2[j] = ym1[j]; ym1[j] = y0[j]; }
                        u32x4 w; w.x = pk2(o[0], o[1]); w.y = pk2(o[2], o[3]); w.z = pk2(o[4], o[5]); w.w = pk2(o[6], o[7]);
                        *(u32x4*)(AO + off) = w; } }
                }
            }
        }
        SEAM(pb + 2);
        if (even_layer) {
            if (IN(pb + 3)) { PH_SETUP(); bf16* AO = (bf16*)(ws + WS_AO); const bf16* OB = (const bf16*)(ws + WS_OB); const float* LSE = (const float*)(ws + WS_LSE);
                for (int rb = 0; rb < 16; rb += 2) {
                  float lq[2][3][3]; u32x4 oq[2][3][3];
#pragma unroll
                  for (int rr = 0; rr < 2; ++rr) { const size_t row = (size_t)gw * 16 + rb + rr;
#pragma unroll
                      for (int j = 0; j < 3; ++j) { const int c = lane + 64 * j, h = c >> 4;
#pragma unroll
                          for (int b3 = 0; b3 < 3; ++b3) { lq[rr][j][b3] = LSE[(size_t)b3 * MTOK * NAH + row * NAH + h]; oq[rr][j][b3] = *(const u32x4*)(OB + (size_t)b3 * MTOK * AW + row * AW + 8 * c); } } }
#pragma unroll
                  for (int rr = 0; rr < 2; ++rr) { const size_t row = (size_t)gw * 16 + rb + rr;
#pragma unroll
                    for (int j = 0; j < 3; ++j) { const int c = lane + 64 * j;
                        const float l0 = lq[rr][j][0], l1 = lq[rr][j][1], l2 = lq[rr][j][2];
                        const float mx = fmaxf(l0, fmaxf(l1, l2)); float e0 = fast_exp(l0 - mx), e1 = fast_exp(l1 - mx), e2 = fast_exp(l2 - mx);
                        const float inv = 1.0f / (e0 + e1 + e2); e0 *= inv; e1 *= inv; e2 *= inv;
                        const u32x4 a = oq[rr][j][0], bq = oq[rr][j][1], cq = oq[rr][j][2];
                        u32x4 w;
#pragma unroll
                        for (int q = 0; q < 4; ++q) w[q] = pk2(e0 * bf_lo(a[q]) + e1 * bf_lo(bq[q]) + e2 * bf_lo(cq[q]), e0 * bf_hi(a[q]) + e1 * bf_hi(bq[q]) + e2 * bf_hi(cq[q]));
                        *(u32x4*)(AO + row * DM + 8 * c) = w; } } }
            }
            SEAM(pb + 3);
        }
        if (IN(pb + 4)) { PH_SETUP(); const bf16* AO = (const bf16*)(ws + WS_AO); bf16* xb = (bf16*)(ws + WS_XB); bf16* xw = args.dry ? (bf16*)(ws + WS_OB) : xb;
            const bf16* wo = even_layer ? (const bf16*)(ws + WS_WOUTE + li * SZ_WSQ) : (const bf16*)(ws + WS_WOUTO + li * SZ_WSQ);
            pg8::Gemm g{AO, wo, MTOK, DM, DM}; pg8::StaticOrder S; S.init(MTOK, DM, G, bx);
            pg8::EpiRes E{xb, xw, mv + 2 * DM, 6 * DM, (bf16*)(ws + WS_H), mv + 3 * DM, 6 * DM, (u64*)(ws + WS_SSQ) + (size_t)(2 * layer) * MTOK, ldsl + LDSCTL_OFF + 1024};
            pg8::gemm_phase<pg8::EpiRes, pg8::StaticOrder, true, true>(ldsl + RING_OFF, g, S, E, tid);
        }
        SEAM(pb + 4);
        if (IN(pb + 6)) { PH_SETUP(); const bf16* Hb = (const bf16*)(ws + WS_H); bf16* Zb = (bf16*)(ws + WS_Z);
            pg8::Gemm g{Hb, (const bf16*)(ws + WS_WGU + layer * SZ_WGU), MTOK, NGU, DM}; pg8::StaticOrder S; S.init(MTOK, NGU, G, bx);
            pg8::EpiGU E{Zb, NormIn{(const u64*)(ws + WS_SSQ) + (size_t)(2 * layer) * MTOK, (const i64*)(ws + WS_BIASR) + BIAS_GU + (size_t)layer * 4 * NGU, NGU, ldsl + LDSCTL_OFF + 1024}};
            pg8::gemm_phase<pg8::EpiGU, pg8::StaticOrder, true, true>(ldsl + RING_OFF, g, S, E, tid);
        }
        SEAM(pb + 6);
        if (IN(pb + 7)) { PH_SETUP(); const bf16* Zb = (const bf16*)(ws + WS_Z); bf16* xb = (bf16*)(ws + WS_XB); bf16* xw = args.dry ? (bf16*)(ws + WS_OB) : xb;
            pg8::Gemm g{Zb, (const bf16*)(ws + WS_WD + layer * SZ_WD), MTOK, DM, DFF}; pg8::StaticOrder S; S.init(MTOK, DM, G, bx);
            pg8::EpiRes E{xb, xw, mv + 5 * DM, 6 * DM, layer < 3 ? (bf16*)(ws + WS_H) : (bf16*)nullptr, mv + 4 * 6 * DM, 6 * DM, (u64*)(ws + WS_SSQ) + (size_t)(2 * layer + 1) * MTOK, ldsl + LDSCTL_OFF + 1024};
            pg8::gemm_phase<pg8::EpiRes, pg8::StaticOrder, true, true>(ldsl + RING_OFF, g, S, E, tid);
        }
        SEAM(pb + 7);
    }
    if (IN(35)) { OPAQUE_TID(); unsigned char* ws = KWS(); final_rows(gw, lane, (const bf16*)(ws + WS_XB), KOUT(), (const float*)KIN(I_FNORM), (const u64*)(ws + WS_SSQ) + (size_t)7 * MTOK); }
#undef IN
#undef SEAM
}

extern "C" void kernel_launch(void* const* d_in, const int* in_sizes, int n_in, void* d_out, int out_size, void* d_ws, size_t ws_size, hipStream_t stream) {
    static int grid = 0;
    if (grid == 0) {
        if (n_in != 18 || out_size != MTOK * DM || ws_size < WS_END) { fprintf(stderr, "kernel_launch: unexpected shapes (n_in %d, out %d, ws %zu; need ws >= %zu)\n", n_in, out_size, ws_size, (size_t)WS_END); grid = -1; return; }
        int dev = 0, cus = 0, per_cu = 0;
        if (hipGetDevice(&dev) != hipSuccess || hipDeviceGetAttribute(&cus, hipDeviceAttributeMultiprocessorCount, dev) != hipSuccess) { grid = -1; return; }
        if (hipFuncSetAttribute((const void*)mega_fwd, hipFuncAttributeMaxDynamicSharedMemorySize, LDS_BYTES) != hipSuccess) { fprintf(stderr, "kernel_launch: hipFuncSetAttribute failed\n"); grid = -1; return; }
        if (hipOccupancyMaxActiveBlocksPerMultiprocessor(&per_cu, (const void*)mega_fwd, NWAVES * 64, LDS_BYTES) != hipSuccess || per_cu < 1)
            fprintf(stderr, "kernel_launch: note: occupancy query reports %d workgroups per CU\n", per_cu);
        (void)hipGetLastError();
        grid = cus;
        if (grid != 256) fprintf(stderr, "kernel_launch: %d CUs (built for 256)\n", grid);
    }
    if (grid < 0) return;
    (void)in_sizes;
    if (hipMemsetAsync((char*)d_ws + WS_CTL, 0, CTL_ZERO_BYTES, stream) != hipSuccess) return;
    Args a{};
    for (int i = 0; i < 18; ++i) a.in[i] = d_in[i];
    a.out = (float*)d_out; a.ws = (unsigned char*)d_ws;
#if MK_PER_PHASE
    for (int p = 0; p < 36; ++p) { if (p >= 3 && p < 35) { const int k = (p - 3) % 8, l = (p - 3) / 8; if (k == 0 || k == 5 || (k == 3 && (l & 1))) continue; }
        a.ph_lo = p; a.ph_hi = p + 1; hipLaunchKernelGGL(mega_fwd, dim3(grid), dim3(NWAVES * 64), LDS_BYTES, stream, a); }
#else
    a.ph_lo = 0; a.ph_hi = 36;
    hipLaunchKernelGGL(mega_fwd, dim3(grid), dim3(NWAVES * 64), LDS_BYTES, stream, a);
    for (int r = 0; r < PROBE_REPS; ++r) { (void)hipMemsetAsync((char*)d_ws + WS_CTL, 0, CTL_ZERO_BYTES, stream);
        a.ph_lo = PROBE_LO; a.ph_hi = PROBE_HI; a.dry = PROBE_DRY; hipLaunchKernelGGL(mega_fwd, dim3(grid), dim3(NWAVES * 64), LDS_BYTES, stream, a); }
#endif
}
```

```cpp
#include <hip/hip_runtime.h>
#include <cstdio>
#include <cstdint>

#ifndef PROBE_REPS
#define PROBE_REPS 0
#define PROBE_LO 0
#define PROBE_HI 0
#define PROBE_DRY 0
#endif
#ifndef MK_PER_PHASE
#define MK_PER_PHASE 0
#endif

constexpr int BATCH = 4, SEQ = 8192, DM = 2048, MTOK = BATCH * SEQ, DFF = 5632, HD = 128, NAH = 12, AW = 1536, SW = 512, MIXIN = 5632, CIN = 6144, NGU = 2 * DFF;
constexpr int ZP = 5632;
constexpr float EPS = 1e-6f;

typedef unsigned short bf16;
typedef short bf16x8 __attribute__((ext_vector_type(8)));
typedef short s16x4 __attribute__((ext_vector_type(4)));
typedef float f32x4 __attribute__((ext_vector_type(4)));
typedef float f32x16 __attribute__((ext_vector_type(16)));
typedef float f32x2 __attribute__((ext_vector_type(2)));
typedef unsigned u32x4 __attribute__((ext_vector_type(4)));
typedef unsigned u32x2 __attribute__((ext_vector_type(2)));
#define LAS __attribute__((address_space(3)))
#define GAS __attribute__((address_space(1)))

__device__ __forceinline__ unsigned cvt_pk_bf16(float lo, float hi) { unsigned r; asm volatile("v_cvt_pk_bf16_f32 %0, %1, %2" : "=v"(r) : "v"(lo), "v"(hi)); return r; }
__device__ __forceinline__ float bf_lo(unsigned w) { return __uint_as_float(w << 16); }
__device__ __forceinline__ float bf_hi(unsigned w) { return __uint_as_float(w & 0xffff0000u); }
__device__ __forceinline__ float fast_exp(float x) { return __builtin_amdgcn_exp2f(x * 1.4426950408889634f); }
__device__ __forceinline__ float gelu_tanh(float x) {
    const float t = x * (1.0f + 0.044715f * x * x) * (-2.0f * 0.7978845608028654f * 1.4426950408889634f);
    return x * __builtin_amdgcn_rcpf(1.0f + __builtin_amdgcn_exp2f(t));
}
__device__ __forceinline__ float silu_f(float x) { return x * __builtin_amdgcn_rcpf(1.0f + __builtin_amdgcn_exp2f(x * -1.4426950408889634f)); }

template <int O> __device__ __forceinline__ float swz_xor(float v) { return __int_as_float(__builtin_amdgcn_ds_swizzle(__float_as_int(v), (O << 10) | 0x1f)); }
__device__ __forceinline__ float xor1(float v) { return __int_as_float(__builtin_amdgcn_update_dpp(0, __float_as_int(v), 0xB1, 0xf, 0xf, true)); }
__device__ __forceinline__ float half_sum(float v) { auto rr = __builtin_amdgcn_permlane32_swap(__float_as_uint(v), __float_as_uint(v), false, false); return __uint_as_float(rr[0]) + __uint_as_float(rr[1]); }
typedef unsigned u64; typedef int i64;
constexpr float SSQ_SCALE = 1024.0f, BIAS_SCALE = 1048576.0f;
struct NormIn { const u64* ssq; const i64* bias; int N; LAS unsigned char* stg;
    __device__ __forceinline__ void stage(int pm, int pn, int lane) const {
        __builtin_amdgcn_global_load_lds((const unsigned*)(ssq + (size_t)pm * 256 + lane * 4), (LAS unsigned*)stg, 16, 0, 0);
        __builtin_amdgcn_global_load_lds((const unsigned*)(bias + (size_t)(pm >> 5) * N + pn * 256 + lane * 4), (LAS unsigned*)(stg + 1024), 16, 0, 0); }
    __device__ __forceinline__ float rs(int rowl) const;
    __device__ __forceinline__ f32x4 bias4l(int coll) const;
};
__device__ __forceinline__ float rs_of(const u64* ssq, int row) { return __builtin_amdgcn_rsqf((float)ssq[row] * (1.0f / (SSQ_SCALE * DM)) + EPS); }
typedef int i32x4 __attribute__((ext_vector_type(4)));
__device__ __forceinline__ f32x4 bias4(const i64* p) { const i32x4 v = *(const i32x4*)p; return (f32x4){(float)v.x, (float)v.y, (float)v.z, (float)v.w} * (1.0f / BIAS_SCALE); }
__device__ __forceinline__ float NormIn::rs(int rowl) const { return __builtin_amdgcn_rsqf((float)((const LAS u64*)stg)[rowl] * (1.0f / (SSQ_SCALE * DM)) + EPS); }
__device__ __forceinline__ f32x4 NormIn::bias4l(int coll) const { const i32x4 v = *(const LAS i32x4*)(stg + 1024 + coll * 4); return (f32x4){(float)v.x, (float)v.y, (float)v.z, (float)v.w} * (1.0f / BIAS_SCALE); }
__device__ __forceinline__ void ssq_add(u64* p, float v) { __hip_atomic_fetch_add(p, (u64)(v * SSQ_SCALE + 0.5f), __ATOMIC_RELAXED, __HIP_MEMORY_SCOPE_AGENT); }

namespace pg8 {
constexpr int BM = 256, BK = 64, HALF = 128, HTB = HALF * BK * 2, STAGE_BYTES = 8 * HTB, NXCD = 8, WGM = 4;
__host__ __device__ __forceinline__ int lds_byte(int r, int c) { const int st = (r >> 4) * 2 + (c >> 5), rr = r & 15, cc = c & 31, ob = rr * 64 + cc * 2; return st * 1024 + (ob ^ (((ob >> 9) & 1) << 5)); }
__host__ __device__ __forceinline__ void stage_rc(int b, int& R, int& C) { const int st = b / 1024, sb = b % 1024, swz = sb ^ (((sb >> 9) & 1) << 5); R = (st >> 1) * 16 + swz / 64; C = (st & 1) * 32 + (swz % 64) / 2; }
__host__ __device__ __forceinline__ int perm32(int rho) { const int n = rho >> 4, i = rho & 15; return 8 * (i >> 2) + 4 * n + (i & 3); }

struct Unit { int pm, pn; };
struct Gemm { const bf16* A; const bf16* Bt; int M, N, K; };

struct StaticOrder {
    int nM, nN, nwg, G, c;
    __host__ __device__ void init(int M, int N, int G_, int c_) { nM = M / BM; nN = N / BM; nwg = nM * nN; G = G_; c = c_; }
    __host__ __device__ bool next(int i, Unit& u) const {
        const long L = (long)i * G + c; if (L >= nwg) return false;
        int wgid = (int)L; { const int q = nwg / NXCD, r = nwg % NXCD, xcd = wgid % NXCD, off = wgid / NXCD; wgid = (xcd < r ? xcd * (q + 1) : r * (q + 1) + (xcd - r) * q) + off; }
        const int nig = WGM * nN, gid = wgid / nig, fm = gid * WGM, gsz = (nM - fm) < WGM ? (nM - fm) : WGM;
        u.pm = fm + ((wgid % nig) % gsz); u.pn = (wgid % nig) / gsz; return true;
    }
    __device__ __forceinline__ void a_ready(const Unit&) const {}
    __device__ __forceinline__ void done(const Unit&) const {}
};

__device__ __forceinline__ void store8(bf16* p, f32x4 v0, f32x4 v1) {
    u32x4 w; w.x = cvt_pk_bf16(v0[0], v0[1]); w.y = cvt_pk_bf16(v0[2], v0[3]); w.z = cvt_pk_bf16(v1[0], v1[1]); w.w = cvt_pk_bf16(v1[2], v1[3]);
    *(u32x4*)p = w;
}

struct EpiInE {
    bf16* Z; const float* RT; NormIn nb;
    __device__ __forceinline__ void stage(const Unit& u, int lane) const { nb.stage(u.pm, u.pn, lane); }
    __device__ __forceinline__ void operator()(const f32x4 (&acc)[2][2][4][2], const Unit& u, int wr, int wc, int fr, int fq) const {
        const int row0 = u.pm * BM + wr * 64 + fr, col0 = u.pn * BM + wc * 32 + 8 * fq;
        f32x4 bv[2][2];
        { const int bp = wc * 32 + 4 * fq;
#pragma unroll
          for (int bj = 0; bj < 2; ++bj)
#pragma unroll
              for (int n = 0; n < 2; ++n) bv[bj][n] = nb.bias4l(bp + bj * HALF + n * 16); }
        if (u.pn < 12) {
            const bool rot = (wc == 0);
#pragma unroll
            for (int ai = 0; ai < 2; ++ai) {
                f32x4 csq[4], snq[4];
#pragma unroll
                for (int m = 0; m < 4; ++m) { csq[m] = (f32x4){1.f, 1.f, 1.f, 1.f}; snq[m] = (f32x4){0.f, 0.f, 0.f, 0.f}; }
                if (rot) {
#pragma unroll
                    for (int m = 0; m < 4; ++m) { const int row = row0 + ai * HALF + m * 16; csq[m] = *(const f32x4*)(RT + (size_t)row * 32 + 4 * fq); snq[m] = *(const f32x4*)(RT + (size_t)row * 32 + 16 + 4 * fq); } }
#pragma unroll
                for (int m = 0; m < 4; ++m) { const int row = row0 + ai * HALF + m * 16; bf16* rowp = Z + (size_t)row * ZP + col0; const float rs = nb.rs(row - u.pm * BM);
                    const f32x4 cs = csq[m], sn = snq[m];
#pragma unroll
                    for (int bj = 0; bj < 2; ++bj) { const f32x4 t1 = acc[ai][bj][m][0] * rs + bv[bj][0], t2 = acc[ai][bj][m][1] * rs + bv[bj][1];
                        store8(rowp + bj * HALF, t1 * cs - t2 * sn, t2 * cs + t1 * sn); } } }
        } else if (u.pn < 18) {
#pragma unroll
            for (int ai = 0; ai < 2; ++ai)
#pragma unroll
                for (int m = 0; m < 4; ++m) { const int row = row0 + ai * HALF + m * 16; bf16* rowp = Z + (size_t)row * ZP + col0; const float rs = nb.rs(row - u.pm * BM);
#pragma unroll
                    for (int bj = 0; bj < 2; ++bj) store8(rowp + bj * HALF, acc[ai][bj][m][0] * rs + bv[bj][0], acc[ai][bj][m][1] * rs + bv[bj][1]); }
        } else {
#pragma unroll
            for (int ai = 0; ai < 2; ++ai)
#pragma unroll
                for (int m = 0; m < 4; ++m) { const int row = row0 + ai * HALF + m * 16; bf16* rowp = Z + (size_t)row * ZP + col0; const float rs = nb.rs(row - u.pm * BM);
#pragma unroll
                    for (int bj = 0; bj < 2; ++bj) { f32x4 v0 = acc[ai][bj][m][0] * rs + bv[bj][0], v1 = acc[ai][bj][m][1] * rs + bv[bj][1];
#pragma unroll
                        for (int j = 0; j < 4; ++j) { v0[j] = gelu_tanh(v0[j]); v1[j] = gelu_tanh(v1[j]); }
                        store8(rowp + bj * HALF, v0, v1); } }
        }
    }
};
struct EpiInO {
    bf16* GB; bf16* Y; NormIn nb;
    __device__ __forceinline__ void stage(const Unit& u, int lane) const { nb.stage(u.pm, u.pn, lane); }
    __device__ __forceinline__ void operator()(const f32x4 (&acc)[2][2][4][2], const Unit& u, int wr, int wc, int fr, int fq) const {
        const int row0 = u.pm * BM + wr * 64 + fr;
        f32x4 bv[2][2];
        { const int bp = wc * 32 + 4 * fq;
#pragma unroll
          for (int bj = 0; bj < 2; ++bj)
#pragma unroll
              for (int n = 0; n < 2; ++n) bv[bj][n] = nb.bias4l(bp + bj * HALF + n * 16); }
        if (u.pn < 8) { const int col0 = u.pn * BM + wc * 32 + 8 * fq;
#pragma unroll
            for (int ai = 0; ai < 2; ++ai)
#pragma unroll
                for (int m = 0; m < 4; ++m) { const int row = row0 + ai * HALF + m * 16; bf16* rowp = GB + (size_t)row * DM + col0; const float rs = nb.rs(row - u.pm * BM);
#pragma unroll
                    for (int bj = 0; bj < 2; ++bj) store8(rowp + bj * HALF, acc[ai][bj][m][0] * rs + bv[bj][0], acc[ai][bj][m][1] * rs + bv[bj][1]); }
        } else { const int col0 = (u.pn - 8) * HALF + wc * 32 + 8 * fq;
#pragma unroll
            for (int ai = 0; ai < 2; ++ai)
#pragma unroll
                for (int m = 0; m < 4; ++m) { const int row = row0 + ai * HALF + m * 16; const float rs = nb.rs(row - u.pm * BM);
                    store8(Y + (size_t)row * DM + col0, (acc[ai][0][m][0] * rs + bv[0][0]) * (acc[ai][1][m][0] * rs + bv[1][0]), (acc[ai][0][m][1] * rs + bv[0][1]) * (acc[ai][1][m][1] * rs + bv[1][1])); }
        }
    }
};
struct EpiGU {
    bf16* Hd; NormIn nb;
    __device__ __forceinline__ void stage(const Unit& u, int lane) const { nb.stage(u.pm, u.pn, lane); }
    __device__ __forceinline__ void operator()(const f32x4 (&acc)[2][2][4][2], const Unit& u, int wr, int wc, int fr, int fq) const {
        const int row0 = u.pm * BM + wr * 64 + fr, col0 = u.pn * HALF + wc * 32 + 8 * fq;
        f32x4 bv[2][2];
        { const int bp = wc * 32 + 4 * fq;
#pragma unroll
          for (int bj = 0; bj < 2; ++bj)
#pragma unroll
              for (int n = 0; n < 2; ++n) bv[bj][n] = nb.bias4l(bp + bj * HALF + n * 16); }
#pragma unroll
        for (int ai = 0; ai < 2; ++ai)
#pragma unroll
            for (int m = 0; m < 4; ++m) { const int row = row0 + ai * HALF + m * 16; const float rs = nb.rs(row - u.pm * BM); f32x4 v0, v1;
                const f32x4 g0 = acc[ai][0][m][0] * rs + bv[0][0], g1 = acc[ai][0][m][1] * rs + bv[0][1], u0 = acc[ai][1][m][0] * rs + bv[1][0], u1 = acc[ai][1][m][1] * rs + bv[1][1];
#pragma unroll
                for (int j = 0; j < 4; ++j) { v0[j] = silu_f(g0[j]) * u0[j]; v1[j] = silu_f(g1[j]) * u1[j]; }
                store8(Hd + (size_t)row * ZP + col0, v0, v1); }
    }
};
struct EpiRes {
    const bf16* xin; bf16* xout; const float* gate; int gstride; bf16* Hn; const float* an; int astride; u64* ssq; LAS unsigned char* stg;
    __device__ __forceinline__ void stage(const Unit& u, int lane) const {
        __builtin_amdgcn_global_load_lds((const unsigned*)(gate + (size_t)(u.pm >> 5) * gstride + u.pn * BM + lane * 4), (LAS unsigned*)stg, 16, 0, 0);
        __builtin_amdgcn_global_load_lds((const unsigned*)((Hn ? an : gate) + (size_t)(u.pm >> 5) * astride + u.pn * BM + lane * 4), (LAS unsigned*)(stg + 1024), 16, 0, 0); }
    __device__ __forceinline__ void operator()(const f32x4 (&acc)[2][2][4][2], const Unit& u, int wr, int wc, int fr, int fq) const {
        const int row0 = u.pm * BM + wr * 64 + fr, col0 = u.pn * BM + wc * 32 + 8 * fq;
        const LAS unsigned char* gl = stg + (wc * 32 + 8 * fq) * 4;
        u32x4 xq[2][4][2];
#pragma unroll
        for (int ai = 0; ai < 2; ++ai)
#pragma unroll
            for (int m = 0; m < 4; ++m)
#pragma unroll
                for (int bj = 0; bj < 2; ++bj) xq[ai][m][bj] = *(const u32x4*)(xin + (size_t)(row0 + ai * HALF + m * 16) * DM + col0 + bj * HALF);
#pragma unroll
        for (int ai = 0; ai < 2; ++ai) {
#pragma unroll
            for (int m = 0; m < 4; ++m) { const int row = row0 + ai * HALF + m * 16; const size_t off = (size_t)row * DM + col0; float ps = 0.f;
#pragma unroll
                for (int bj = 0; bj < 2; ++bj) { const u32x4 xi = xq[ai][m][bj];
                    const f32x4 g0 = *(const LAS f32x4*)(gl + bj * HALF * 4), g1 = *(const LAS f32x4*)(gl + bj * HALF * 4 + 16);
                    const f32x4 x0 = (f32x4){bf_lo(xi.x), bf_hi(xi.x), bf_lo(xi.y), bf_hi(xi.y)} + g0 * acc[ai][bj][m][0];
                    const f32x4 x1 = (f32x4){bf_lo(xi.z), bf_hi(xi.z), bf_lo(xi.w), bf_hi(xi.w)} + g1 * acc[ai][bj][m][1];
                    u32x4 w; w.x = cvt_pk_bf16(x0[0], x0[1]); w.y = cvt_pk_bf16(x0[2], x0[3]); w.z = cvt_pk_bf16(x1[0], x1[1]); w.w = cvt_pk_bf16(x1[2], x1[3]);
                    *(u32x4*)(xout + off + bj * HALF) = w;
                    const f32x4 r0 = (f32x4){bf_lo(w.x), bf_hi(w.x), bf_lo(w.y), bf_hi(w.y)}, r1 = (f32x4){bf_lo(w.z), bf_hi(w.z), bf_lo(w.w), bf_hi(w.w)};
                    ps += ((r0[0] * r0[0] + r0[1] * r0[1]) + (r0[2] * r0[2] + r0[3] * r0[3])) + ((r1[0] * r1[0] + r1[1] * r1[1]) + (r1[2] * r1[2] + r1[3] * r1[3]));
                    if (Hn) { const f32x4 a0 = *(const LAS f32x4*)(gl + 1024 + bj * HALF * 4), a1 = *(const LAS f32x4*)(gl + 1024 + bj * HALF * 4 + 16); store8(Hn + off + bj * HALF, r0 * a0, r1 * a1); } }
                ps += swz_xor<16>(ps); ps = half_sum(ps); if (fq == 0) ssq_add(ssq + row, ps);
                asm volatile("" ::: "memory"); } }
    }
};

template <class Epi, class Sched, bool ALIGN_EPI = false, bool SP2 = false>
__device__ __forceinline__ void gemm_phase(LAS unsigned char* lds, const Gemm g, const Sched& S, const Epi& E, const int tid) {
    const int wid = __builtin_amdgcn_readfirstlane(tid >> 6), lane = tid & 63, wr = wid >> 2, wc = wid & 3, fr = lane & 15, fq = lane >> 4;
    const int K = g.K, nt = K / BK;
    unsigned voffA[2];
#pragma unroll
    for (int i = 0; i < 2; ++i) { int R, C; stage_rc(tid * 16 + i * 8192, R, C); voffA[i] = (unsigned)(R * K + C) * 2u; }
#define voffB voffA
    const size_t kstep = (size_t)(BK * 2);
    const size_t hstep = (size_t)HALF * K * 2;
    const size_t tstep = 2 * hstep;
    const unsigned ldsw = (unsigned)wid * 1024u;
    const int aoff = lds_byte(wr * 64 + fr, fq * 8), boff = lds_byte(wc * 32 + fr, fq * 8);
#define PG8_SA(b, h) (((b) * 2 + (h)) * HTB)
#define PG8_SB(b, h) ((4 + (b) * 2 + (h)) * HTB)
#define PG8_STAGE(bufoff, gbase, voff) do { _Pragma("unroll") for (int _i = 0; _i < 2; ++_i) \
        __builtin_amdgcn_global_load_lds((const unsigned*)((const char*)(gbase) + (voff)[_i]), (LAS unsigned*)(lds + (bufoff) + ldsw + _i * 8192), 16, 0, 0); } while (0)
#define PG8_LDA(dst, b, h) do { _Pragma("unroll") for (int m = 0; m < 4; ++m) _Pragma("unroll") for (int k = 0; k < 2; ++k) dst[m][k] = *(const LAS bf16x8*)(lds + PG8_SA(b, h) + aoff + m * 2048 + k * 1024); } while (0)
#define PG8_LDB(dst, b, h) do { _Pragma("unroll") for (int n = 0; n < 2; ++n) _Pragma("unroll") for (int k = 0; k < 2; ++k) dst[n][k] = *(const LAS bf16x8*)(lds + PG8_SB(b, h) + boff + n * 2048 + k * 1024); } while (0)
#define PG8_MMA(ai, bj, At, Bt) do { __builtin_amdgcn_s_setprio(1); _Pragma("unroll") for (int m = 0; m < 4; ++m) _Pragma("unroll") for (int n = 0; n < 2; ++n) _Pragma("unroll") for (int k = 0; k < 2; ++k) \
        acc[ai][bj][m][n] = __builtin_amdgcn_mfma_f32_16x16x32_bf16(Bt[n][k], At[m][k], acc[ai][bj][m][n], 0, 0, 0); __builtin_amdgcn_s_setprio(0); } while (0)
#define PG8_WAIT_V(n) asm volatile("s_waitcnt vmcnt(" #n ")" ::: "memory")
#define PG8_WAIT_L(n) asm volatile("s_waitcnt lgkmcnt(" #n ")" ::: "memory")
#define PG8_BAR __builtin_amdgcn_s_barrier()
#define PG8_SCHED __builtin_amdgcn_sched_barrier(0)
    Unit cur, nxt; int ui = 0;
    if (!S.next(0, cur)) return;
    f32x4 acc[2][2][4][2];
#pragma unroll
    for (int a = 0; a < 2; ++a)
#pragma unroll
        for (int b = 0; b < 2; ++b)
#pragma unroll
            for (int m = 0; m < 4; ++m)
#pragma unroll
                for (int n = 0; n < 2; ++n) acc[a][b][m][n] = (f32x4){0.f, 0.f, 0.f, 0.f};
    bf16x8 At[4][2], B0[2][2], B1[2][2];
    const char* cA = (const char*)g.A + (size_t)cur.pm * tstep; const char* cB = (const char*)g.Bt + (size_t)cur.pn * tstep;
    S.a_ready(cur);
    if constexpr (SP2) {
        PG8_STAGE(PG8_SB(0, 0), cB, voffB); PG8_STAGE(PG8_SB(0, 1), cB + hstep, voffB); PG8_STAGE(PG8_SA(0, 0), cA, voffA); PG8_STAGE(PG8_SA(0, 1), cA + hstep, voffA);
        if (wr == 1) PG8_BAR;
        PG8_WAIT_V(2); PG8_BAR;
        PG8_STAGE(PG8_SB(1, 0), cB + kstep, voffB); PG8_STAGE(PG8_SA(1, 0), cA + kstep, voffA); PG8_STAGE(PG8_SB(1, 1), cB + hstep + kstep, voffB);
        PG8_WAIT_V(6); PG8_BAR;
    } else {
        PG8_STAGE(PG8_SB(0, 0), cB, voffB); PG8_STAGE(PG8_SA(0, 0), cA, voffA); PG8_STAGE(PG8_SB(0, 1), cB + hstep, voffB); PG8_STAGE(PG8_SA(0, 1), cA + hstep, voffA);
        if (wr == 1) PG8_BAR;
        PG8_WAIT_V(4); PG8_BAR;
        PG8_STAGE(PG8_SB(1, 0), cB + kstep, voffB); PG8_STAGE(PG8_SA(1, 0), cA + kstep, voffA); PG8_STAGE(PG8_SB(1, 1), cB + hstep + kstep, voffB);
        PG8_WAIT_V(6); PG8_BAR;
    }
    for (;;) {
        const bool has_next = S.next(ui + 1, nxt);
        const char* nA = has_next ? (const char*)g.A + (size_t)nxt.pm * tstep : cA; const char* nB = has_next ? (const char*)g.Bt + (size_t)nxt.pn * tstep : cB;
        for (int t = 0; t < nt; t += 2) {
            const bool last = (t == nt - 2);
            const char* a1 = cA + (size_t)(t + 1) * kstep;
            const char* a2 = last ? nA : cA + (size_t)(t + 2) * kstep; const char* b2 = last ? nB : cB + (size_t)(t + 2) * kstep;
            const char* a3 = a2 + kstep; const char* b3 = b2 + kstep;
            if (last && has_next) S.a_ready(nxt);
            if (last && wid == 0) E.stage(cur, lane);
            if constexpr (SP2) {
            PG8_LDB(B0, 0, 0); PG8_LDB(B1, 0, 1); PG8_SCHED; PG8_LDA(At, 0, 0); PG8_STAGE(PG8_SA(1, 1), a1 + hstep, voffA);
            PG8_WAIT_V(8); PG8_WAIT_L(0); PG8_BAR; PG8_MMA(0, 0, At, B0); PG8_MMA(0, 1, At, B1); PG8_BAR; PG8_SCHED;
            PG8_LDA(At, 0, 1); PG8_STAGE(PG8_SB(0, 0), b2, voffB); PG8_STAGE(PG8_SB(0, 1), b2 + hstep, voffB); PG8_STAGE(PG8_SA(0, 0), a2, voffA);
            PG8_WAIT_V(8); PG8_WAIT_L(0); PG8_BAR; PG8_MMA(1, 0, At, B0); PG8_MMA(1, 1, At, B1); PG8_BAR; PG8_SCHED;
            PG8_LDB(B0, 1, 0); PG8_LDB(B1, 1, 1); PG8_SCHED; PG8_LDA(At, 1, 0); PG8_STAGE(PG8_SA(0, 1), a2 + hstep, voffA);
            PG8_WAIT_V(8); PG8_WAIT_L(0); PG8_BAR; PG8_MMA(0, 0, At, B0); PG8_MMA(0, 1, At, B1); PG8_BAR; PG8_SCHED;
            PG8_LDA(At, 1, 1); PG8_STAGE(PG8_SB(1, 0), b3, voffB); PG8_STAGE(PG8_SB(1, 1), b3 + hstep, voffB); PG8_STAGE(PG8_SA(1, 0), a3, voffA);
            PG8_WAIT_V(8); PG8_WAIT_L(0); PG8_BAR; PG8_MMA(1, 0, At, B0); PG8_MMA(1, 1, At, B1); PG8_BAR; PG8_SCHED;
            } else {
            PG8_LDB(B0, 0, 0); PG8_SCHED; PG8_LDA(At, 0, 0); PG8_STAGE(PG8_SA(1, 1), a1 + hstep, voffA);
            PG8_WAIT_L(8); PG8_BAR; PG8_WAIT_L(0); PG8_MMA(0, 0, At, B0); PG8_BAR; PG8_SCHED;
            PG8_LDB(B1, 0, 1); PG8_STAGE(PG8_SB(0, 0), b2, voffB);
            PG8_BAR; PG8_WAIT_L(0); PG8_MMA(0, 1, At, B1); PG8_BAR;
            PG8_LDA(At, 0, 1); PG8_STAGE(PG8_SA(0, 0), a2, voffA);
            PG8_BAR; PG8_WAIT_L(0); PG8_MMA(1, 0, At, B0); PG8_BAR; PG8_SCHED;
            PG8_STAGE(PG8_SB(0, 1), b2 + hstep, voffB);
            PG8_WAIT_V(6); PG8_BAR; PG8_MMA(1, 1, At, B1); PG8_BAR;
            PG8_LDB(B0, 1, 0); PG8_SCHED; PG8_LDA(At, 1, 0); PG8_STAGE(PG8_SA(0, 1), a2 + hstep, voffA);
            PG8_WAIT_L(8); PG8_BAR; PG8_WAIT_L(0); PG8_MMA(0, 0, At, B0); PG8_BAR; PG8_SCHED;
            PG8_LDB(B1, 1, 1); PG8_STAGE(PG8_SB(1, 0), b3, voffB);
            PG8_BAR; PG8_WAIT_L(0); PG8_MMA(0, 1, At, B1); PG8_BAR;
            PG8_LDA(At, 1, 1); PG8_STAGE(PG8_SA(1, 0), a3, voffA);
            PG8_BAR; PG8_WAIT_L(0); PG8_MMA(1, 0, At, B0); PG8_BAR; PG8_SCHED;
            PG8_STAGE(PG8_SB(1, 1), b3 + hstep, voffB);
            PG8_WAIT_V(6); PG8_BAR; PG8_MMA(1, 1, At, B1); PG8_BAR;
            }
        }
        if constexpr (ALIGN_EPI) { if (wr == 0) PG8_BAR; }
        { int te = threadIdx.x; asm volatile("" : "+v"(te));
          E(acc, cur, wr, wc, te & 15, (te & 63) >> 4); } S.done(cur);
        if (!has_next) break;
#pragma unroll
        for (int a = 0; a < 2; ++a)
#pragma unroll
            for (int b = 0; b < 2; ++b)
#pragma unroll
                for (int m = 0; m < 4; ++m)
#pragma unroll
                    for (int n = 0; n < 2; ++n) acc[a][b][m][n] = (f32x4){0.f, 0.f, 0.f, 0.f};
        cur = nxt; cA = nA; cB = nB; ++ui;
        if constexpr (ALIGN_EPI) { if (wr == 1) PG8_BAR; }
    }
    PG8_WAIT_V(0);
    if constexpr (!ALIGN_EPI) { if (wr == 0) PG8_BAR; }
    PG8_BAR;
#undef voffB
#undef PG8_SA
#undef PG8_SB
#undef PG8_STAGE
#undef PG8_LDA
#undef PG8_LDB
#undef PG8_MMA
#undef PG8_WAIT_V
#undef PG8_WAIT_L
#undef PG8_BAR
#undef PG8_SCHED
}
}

namespace att {
constexpr float SCALE = 0.08838834764831845f;
constexpr float THR = 8.f;
constexpr int NW = 8, QBLK = 32, KVBLK = 64, QB = NW * QBLK;
constexpr int SHM_V = KVBLK * HD * 2, SHM_K = KVBLK * HD * 2;
#define KSWZ(row, colB) ((row) * 256 + ((colB) ^ (((row) & 7) << 4)))
#define SBAR() __builtin_amdgcn_sched_barrier(0)
__device__ __forceinline__ int v_st(int k, int c) { const int kk = (k & ~0xC) | ((k & 4) << 1) | ((k & 8) >> 1); return ((kk >> 3) * 4 + (c >> 5)) * 512 + ((kk & 7) * 32 + (c & 31)) * 2; }
__device__ __forceinline__ int v_rd_base(int lane) { return ((lane & 3) << 3) | (((lane >> 2) & 3) << 6) | (((lane >> 4) & 1) << 5) | (((lane >> 5) & 1) << 8); }
constexpr int v_rd_off(int d0, int ks, int half) { return d0 * 512 + ks * 4096 + half * 2048; }
__device__ __forceinline__ int crow(int r, int hi) { return (r & 3) + 8 * (r >> 2) + 4 * hi; }
__device__ __forceinline__ unsigned cvtpk(float lo, float hi) { unsigned r; asm volatile("v_cvt_pk_bf16_f32 %0, %1, %2" : "=v"(r) : "v"(lo), "v"(hi)); return r; }
__device__ __forceinline__ bf16x8 ld8(const bf16* p) { return *reinterpret_cast<const bf16x8*>(p); }
template <bool CAUSAL_SIDE>
__device__ __forceinline__ void mask_tile(f32x16& p0, f32x16& p1, int dq, int W) {
    const float NEG = -__builtin_inff();
#pragma unroll
    for (int r = 0; r < 16; ++r) {
        const int c = (r & 3) + 8 * (r >> 2);
        if (CAUSAL_SIDE) { if (dq < c) p0[r] = NEG; if (dq < c + 32) p1[r] = NEG; }
        else { if (dq >= c + W) p0[r] = NEG; if (dq >= c + 32 + W) p1[r] = NEG; }
    }
}
__device__ __forceinline__ void partialSM(f32x16& p0, f32x16& p1, float& m_reg, float& mn, float& alpha) {
    float pmax = p0[0]; for (int r = 1; r < 16; ++r) pmax = fmaxf(pmax, p0[r]); for (int r = 0; r < 16; ++r) pmax = fmaxf(pmax, p1[r]);
    { auto rr = __builtin_amdgcn_permlane32_swap(__float_as_uint(pmax), __float_as_uint(pmax), false, false);
      pmax = fmaxf(__uint_as_float(rr[0]), __uint_as_float(rr[1])); }
    constexpr float C2 = 1.4426950408889634f * SCALE;
    if (__builtin_expect(__all((pmax - m_reg) * SCALE <= THR), 1)) { mn = m_reg; alpha = 1.f; }
    else { mn = fmaxf(m_reg, pmax); alpha = __builtin_amdgcn_exp2f((m_reg - mn) * C2); m_reg = mn; }
    const float mnL = -mn * C2;
    for (int r = 0; r < 16; ++r) p0[r] = fmaf(p0[r], C2, mnL); for (int r = 0; r < 16; ++r) p1[r] = fmaf(p1[r], C2, mnL);
    for (int r = 0; r < 16; ++r) p0[r] = __builtin_amdgcn_exp2f(p0[r]);
}
__device__ __forceinline__ void finishSM(f32x16& p0, f32x16& p1, float alpha, float& l_reg, bf16x8& pa0, bf16x8& pa1, bf16x8& pa2, bf16x8& pa3) {
    for (int r = 0; r < 16; ++r) p1[r] = __builtin_amdgcn_exp2f(p1[r]);
    float ps = 0; for (int r = 0; r < 16; ++r) ps += p0[r]; for (int r = 0; r < 16; ++r) ps += p1[r];
    { auto rr = __builtin_amdgcn_permlane32_swap(__float_as_uint(ps), __float_as_uint(ps), false, false);
      ps = __uint_as_float(rr[0]) + __uint_as_float(rr[1]); }
    l_reg = l_reg * alpha + ps;
#define PK4(P, B_, OUT) do { unsigned a0 = cvtpk(P[B_+0], P[B_+1]), a1 = cvtpk(P[B_+2], P[B_+3]);                          \
        unsigned b0 = cvtpk(P[B_+4], P[B_+5]), b1 = cvtpk(P[B_+6], P[B_+7]);                                             \
        auto r0 = __builtin_amdgcn_permlane32_swap(a0, b0, false, false); auto r1 = __builtin_amdgcn_permlane32_swap(a1, b1, false, false); \
        u32x4 w = {r0[0], r1[0], r0[1], r1[1]}; OUT = *reinterpret_cast<bf16x8*>(&w); } while (0)
    PK4(p0, 0, pa0); PK4(p0, 8, pa1); PK4(p1, 0, pa2); PK4(p1, 8, pa3);
#undef PK4
}
template <int KB, bool SK>
__device__ __forceinline__ void qkt(f32x16& p0, f32x16& p1, const char* K_lds, int r32, int hi, const bf16x8* qr, bool act) {
    if (SK && !act) { const float NEG = -__builtin_inff();
#pragma unroll
        for (int r = 0; r < 16; ++r) { p0[r] = NEG; p1[r] = NEG; } return; }
    p0 = f32x16{}; p1 = f32x16{};
    const char* kb[4];
#pragma unroll
    for (int dd = 0; dd < 4; ++dd) kb[dd] = K_lds + KB * SHM_K + KSWZ(r32, (dd * 16 + hi * 8) * 2);
#pragma unroll
    for (int d0 = 0; d0 < 8; ++d0) { const char* a = kb[d0 & 3] + (d0 >> 2) * 128;
        bf16x8 b0 = *reinterpret_cast<const bf16x8*>(a);
        bf16x8 b1 = *reinterpret_cast<const bf16x8*>(a + 32 * 256);
        p0 = __builtin_amdgcn_mfma_f32_32x32x16_bf16(b0, qr[d0], p0, 0, 0, 0);
        p1 = __builtin_amdgcn_mfma_f32_32x32x16_bf16(b1, qr[d0], p1, 0, 0, 0); }
}
#define TRRD(dst, off) asm volatile("ds_read_b64_tr_b16 %0, %1 offset:%2" : "=&v"(dst) : "v"(vb0), "i"(off) : "memory")
#define PV_D0(VBv, d0, oo) do { s16x4 l0, l1, l2, l3, h0, h1, h2, h3; constexpr int b_ = (VBv) * att::SHM_V + att::v_rd_off(d0, 0, 0); \
        TRRD(l0, b_); TRRD(h0, b_ + 2048); TRRD(l1, b_ + 4096); TRRD(h1, b_ + 6144); TRRD(l2, b_ + 8192); TRRD(h2, b_ + 10240); TRRD(l3, b_ + 12288); TRRD(h3, b_ + 14336); \
        asm volatile("s_waitcnt lgkmcnt(0)" ::: "memory"); SBAR(); \
        oo = __builtin_amdgcn_mfma_f32_32x32x16_bf16(pa0, (bf16x8){l0[0], l0[1], l0[2], l0[3], h0[0], h0[1], h0[2], h0[3]}, oo, 0, 0, 0);   \
        oo = __builtin_amdgcn_mfma_f32_32x32x16_bf16(pa1, (bf16x8){l1[0], l1[1], l1[2], l1[3], h1[0], h1[1], h1[2], h1[3]}, oo, 0, 0, 0);   \
        oo = __builtin_amdgcn_mfma_f32_32x32x16_bf16(pa2, (bf16x8){l2[0], l2[1], l2[2], l2[3], h2[0], h2[1], h2[2], h2[3]}, oo, 0, 0, 0);   \
        oo = __builtin_amdgcn_mfma_f32_32x32x16_bf16(pa3, (bf16x8){l3[0], l3[1], l3[2], l3[3], h3[0], h3[1], h3[2], h3[3]}, oo, 0, 0, 0); } while (0)

struct BlockRef { int tok0, h, br, P0, dil; };
struct Bases { const bf16* Z; bf16* OB; float* LSE; };
#define BR_PIN(r) ((r).dil * ZP)
#define BR_ZB(r) (B.Z + (size_t)(r).tok0 * ZP + (r).h * HD)
#define BR_Q(r) (BR_ZB(r) + (size_t)(r).P0 * BR_PIN(r))
#define BR_K(r) (BR_ZB(r) + AW)
#define BR_V(r) (BR_ZB(r) + 2 * AW)
#define PVT_D0(VBv, d0, oo) do { s16x4 l0, l1, l2, l3, h0, h1, h2, h3; constexpr int b_ = (VBv) * att::SHM_V + att::v_rd_off(d0, 0, 0); \
        TRRD(l0, b_); TRRD(h0, b_ + 2048); TRRD(l1, b_ + 4096); TRRD(h1, b_ + 6144); TRRD(l2, b_ + 8192); TRRD(h2, b_ + 10240); TRRD(l3, b_ + 12288); TRRD(h3, b_ + 14336); \
        asm volatile("s_waitcnt lgkmcnt(0)" ::: "memory"); SBAR(); \
        oo = __builtin_amdgcn_mfma_f32_32x32x16_bf16((bf16x8){l0[0], l0[1], l0[2], l0[3], h0[0], h0[1], h0[2], h0[3]}, pa0, oo, 0, 0, 0);   \
        oo = __builtin_amdgcn_mfma_f32_32x32x16_bf16((bf16x8){l1[0], l1[1], l1[2], l1[3], h1[0], h1[1], h1[2], h1[3]}, pa1, oo, 0, 0, 0);   \
        oo = __builtin_amdgcn_mfma_f32_32x32x16_bf16((bf16x8){l2[0], l2[1], l2[2], l2[3], h2[0], h2[1], h2[2], h2[3]}, pa2, oo, 0, 0, 0);   \
        oo = __builtin_amdgcn_mfma_f32_32x32x16_bf16((bf16x8){l3[0], l3[1], l3[2], l3[3], h3[0], h3[1], h3[2], h3[3]}, pa3, oo, 0, 0, 0); } while (0)
template <int VB>
__device__ __forceinline__ void pvt_tile(f32x16* o, int vb0, bf16x8 pa0, bf16x8 pa1, bf16x8 pa2, bf16x8 pa3, bool act) {
    if (!act) return;
    PVT_D0(VB, 0, o[0]); PVT_D0(VB, 1, o[1]); PVT_D0(VB, 2, o[2]); PVT_D0(VB, 3, o[3]);
}
constexpr int QST_OFF = 2 * SHM_V + 3 * SHM_K;
__device__ __forceinline__ void swa_item(const BlockRef& cur, const BlockRef& nxt, const Bases& B, char* lds, LAS unsigned char* ldsl, const int tid, const bool first) {
    constexpr int W = 129;
    const int wid = __builtin_amdgcn_readfirstlane(tid >> 6), lane = tid & 63, r32 = lane & 31, hi = lane >> 5;
    const int kb0 = cur.P0 - 128;
    const int qlo = cur.P0 + wid * QBLK, qm = qlo + r32 - 4 * hi;
    char* K_lds = lds + 2 * SHM_V;
    const int vb0 = (int)(uintptr_t)lds + v_rd_base(lane);
    int kpk[2], vpk[2];
#pragma unroll
    for (int i = 0; i < 2; ++i) { const int c = 2 * wid + i;
        const int row = 4 * c + (lane >> 4), c16 = lane & 15; kpk[i] = row * 256 + ((c16 ^ (row & 7)) * 8);
        const int q = c * 64 + lane, sub = q >> 5, r = q & 31, kk = (sub >> 2) * 8 + (r >> 2), c8 = (sub & 3) * 4 + (r & 3), k = (kk & ~0xC) | ((kk & 4) << 1) | ((kk & 8) >> 1);
        vpk[i] = k * 256 + c8 * 8; }
    const unsigned kdst = (unsigned)(2 * SHM_V) + (unsigned)wid * 2048u, vdst = (unsigned)wid * 2048u, qdst = (unsigned)QST_OFF + (unsigned)wid * 8192u;
#define DMA_KX(ref, t) do { const int pin_ = BR_PIN(ref); const int kbc_ = (ref).P0 - 128 + 64 * (t); const bf16* g_ = BR_K(ref) + (long)(kbc_ < 0 ? 0 : kbc_) * pin_; _Pragma("unroll") for (int _i = 0; _i < 2; ++_i) \
        __builtin_amdgcn_global_load_lds((const unsigned*)(g_ + (unsigned)((kpk[_i] >> 8) * pin_ + (kpk[_i] & 255))), (LAS unsigned*)(ldsl + kdst + ((t) % 3) * SHM_K + _i * 1024), 16, 0, 0); } while (0)
#define DMA_VX(ref, t) do { const int pin_ = BR_PIN(ref); const int kbc_ = (ref).P0 - 128 + 64 * (t); const bf16* g_ = BR_V(ref) + (long)(kbc_ < 0 ? 0 : kbc_) * pin_; _Pragma("unroll") for (int _i = 0; _i < 2; ++_i) \
        __builtin_amdgcn_global_load_lds((const unsigned*)(g_ + (unsigned)((vpk[_i] >> 8) * pin_ + (vpk[_i] & 255))), (LAS unsigned*)(ldsl + vdst + ((t) % 2) * SHM_V + _i * 1024), 16, 0, 0); } while (0)
#define DMA_Q(ref) do { const int pin_ = BR_PIN(ref); const bf16* g_ = BR_Q(ref) + (size_t)(wid * QBLK) * pin_; _Pragma("unroll") for (int j_ = 0; j_ < 8; ++j_) { const int row_ = 4 * j_ + (lane >> 4); \
        __builtin_amdgcn_global_load_lds((const unsigned*)(g_ + (unsigned)(row_ * pin_ + (((lane & 15) ^ (row_ & 15)) * 8))), (LAS unsigned*)(ldsl + qdst + j_ * 1024), 16, 0, 0); } } while (0)
#define WAITV(n) asm volatile("s_waitcnt vmcnt(" #n ")" ::: "memory")
#define BARV(n) do { WAITV(n); __builtin_amdgcn_s_barrier(); asm volatile("" ::: "memory"); } while (0)
    if (first) { DMA_Q(cur); DMA_KX(cur, 0); DMA_VX(cur, 0); DMA_KX(cur, 1); WAITV(6); } else { WAITV(9); }
    bf16x8 qr[8];
#pragma unroll
    for (int d0 = 0; d0 < 8; ++d0) qr[d0] = *(const bf16x8*)(lds + qdst + r32 * 256 + (((2 * d0 + hi) ^ (r32 & 15)) << 4));
    asm volatile("s_waitcnt lgkmcnt(0)" ::: "memory");
    float m_reg = -1e30f, l_reg = 0; f32x16 o[4] = {}; bool fresh = true;
#define RESC(a) do { if (__any((a) < 1.f)) { for (int d_ = 0; d_ < 4; ++d_) for (int r = 0; r < 16; ++r) o[d_][r] *= (a); } } while (0)
#define KBASE(t) (kb0 + 64 * (t))
#define ACT(t) (KBASE(t) >= 0 && KBASE(t) <= qlo + QBLK - 1 && KBASE(t) + KVBLK - 1 >= qlo - W + 1)
#define MASKT(P0_, P1_, t) do { const int kb_ = KBASE(t); if (kb_ + KVBLK - 1 > qlo) mask_tile<true>(P0_, P1_, qm - kb_, W); else if (kb_ <= qlo + QBLK - 1 - W) mask_tile<false>(P0_, P1_, qm - kb_, W); } while (0)
#define STEP(t, WAITS, ISSUE) do {                                                                                           \
        WAITS; ISSUE;                                                                                                        \
        if (ACT(t)) { f32x16 p0, p1; float mn, al; bf16x8 pa0, pa1, pa2, pa3;                                                \
            SBAR(); qkt<(t) % 3, false>(p0, p1, K_lds, r32, hi, qr, true);                                                  \
            MASKT(p0, p1, (t)); partialSM(p0, p1, m_reg, mn, al); if (fresh) fresh = false; else RESC(al);                   \
            finishSM(p0, p1, al, l_reg, pa0, pa1, pa2, pa3); SBAR();                                                         \
            pvt_tile<(t) % 2>(o, vb0, pa0, pa1, pa2, pa3, true); } } while (0)
    STEP(0, do { if (first) BARV(2); else BARV(9); } while (0), do { DMA_VX(cur, 1); DMA_KX(cur, 2); } while (0));
    STEP(1, BARV(2), do { DMA_VX(cur, 2); DMA_KX(cur, 3); } while (0));
    STEP(2, BARV(2), do { DMA_VX(cur, 3); DMA_KX(cur, 4); } while (0));
    STEP(3, BARV(2), do { DMA_VX(cur, 4); DMA_KX(cur, 5); } while (0));
    STEP(4, BARV(2), do { DMA_VX(cur, 5); DMA_KX(nxt, 0); } while (0));
    STEP(5, BARV(2), do { DMA_VX(nxt, 0); DMA_KX(nxt, 1); DMA_Q(nxt); } while (0));
    const float inv = __builtin_amdgcn_rcpf(l_reg);
    const int pout = cur.dil * AW;
    char* Orow = (char*)(B.OB + ((size_t)cur.br * MTOK + cur.tok0) * AW + cur.h * HD + (size_t)(cur.P0 + wid * QBLK + r32) * pout) + hi * 16;
#pragma unroll
    for (int d0 = 0; d0 < 4; ++d0)
#pragma unroll
        for (int pr = 0; pr < 2; ++pr) {
            unsigned ax = cvtpk(o[d0][8 * pr + 0] * inv, o[d0][8 * pr + 1] * inv), ay = cvtpk(o[d0][8 * pr + 2] * inv, o[d0][8 * pr + 3] * inv);
            unsigned bx = cvtpk(o[d0][8 * pr + 4] * inv, o[d0][8 * pr + 5] * inv), by = cvtpk(o[d0][8 * pr + 6] * inv, o[d0][8 * pr + 7] * inv);
            auto rx = __builtin_amdgcn_permlane32_swap(ax, bx, false, false); auto ry = __builtin_amdgcn_permlane32_swap(ay, by, false, false);
            u32x4 w = {rx[0], ry[0], rx[1], ry[1]};
            *(u32x4*)(Orow + 16 * (4 * d0 + 2 * pr)) = w; }
    if (hi == 0) B.LSE[((size_t)cur.br * MTOK + cur.tok0) * NAH + cur.h + (size_t)(cur.P0 + wid * QBLK + r32) * (cur.dil * NAH)] = m_reg * SCALE + __builtin_amdgcn_logf(l_reg) * 0.6931471805599453f;
#undef RESC
#undef KBASE
#undef ACT
#undef MASKT
#undef STEP
#undef DMA_KX
#undef DMA_VX
#undef DMA_Q
#undef WAITV
#undef BARV
}
}

constexpr int NWAVES = 8;
constexpr size_t MiB = 1u << 20;
constexpr size_t WS_CTL = 0, CTL_ZERO_BYTES = 3 * MiB + 512 * 1024;
constexpr size_t WS_SSQ = 1 * MiB;
constexpr size_t WS_BIASR = 2 * MiB + 256 * 1024;
constexpr size_t WS_MODV = 8 * MiB;
constexpr size_t WS_ROPE = 9 * MiB;
constexpr size_t WS_SGUW = 13 * MiB;
constexpr size_t WS_LSE = 14 * MiB;
constexpr size_t WS_PART = 20 * MiB;
constexpr size_t WS_W = 44 * MiB;
constexpr size_t SZ_WINE = (size_t)MIXIN * DM * 2, SZ_WSQ = (size_t)DM * DM * 2, SZ_WINO = (size_t)CIN * DM * 2, SZ_WGU = (size_t)NGU * DM * 2, SZ_WD = (size_t)DM * DFF * 2;
constexpr size_t WS_WINE = WS_W, WS_WOUTE = WS_WINE + 2 * SZ_WINE, WS_WINO = WS_WOUTE + 2 * SZ_WSQ, WS_WOUTO = WS_WINO + 2 * SZ_WINO, WS_WGU = WS_WOUTO + 2 * SZ_WSQ, WS_WD = WS_WGU + 4 * SZ_WGU;
constexpr size_t WS_H = 432 * MiB;
constexpr size_t WS_Z = 560 * MiB;
constexpr size_t WS_AO = 944 * MiB;
constexpr size_t WS_OB = 1072 * MiB;
constexpr size_t WS_XB = 1360 * MiB;
constexpr size_t WS_END = 1488 * MiB;
constexpr size_t BIAS_INE = 0, BIAS_INO = BIAS_INE + 2 * 4 * MIXIN, BIAS_GU = BIAS_INO + 2 * 4 * CIN, BIAS_END = BIAS_GU + 4 * 4 * NGU;
static_assert(WS_SSQ + 9 * (size_t)MTOK * sizeof(u64) <= WS_BIASR && WS_BIASR + BIAS_END * sizeof(i64) <= CTL_ZERO_BYTES, "zeroed region");
static_assert(WS_WD + 4 * SZ_WD <= WS_H, "weights fit");
constexpr int CW_TMO = 0, CW_BAR = 4096;
constexpr int RING_OFF = 0, RING_BYTES = 131072;
constexpr int LDSCTL_OFF = 147456, MISC_OFF = LDSCTL_OFF + 320;
constexpr int LDS_BYTES = 155648;

typedef GAS unsigned gu32;
#define RLX_AGENT __ATOMIC_RELAXED, __HIP_MEMORY_SCOPE_AGENT
#define LDS_WAIT() asm volatile("s_waitcnt lgkmcnt(0)" ::: "memory")
#define VM_WAIT() asm volatile("s_waitcnt vmcnt(0)" ::: "memory")

#define XB_TMO      128
#define XB_XCNT(j)  (256  + 64 * (j))
#define XB_XSUB(j)  (1280 + 64 * (j))
#define XB_XGEN(j)  (2304 + 64 * (j))
#define XB_TOP      3328
#define XB_TOPGEN   3392
#define XCD_BAR_WORDS 3456
#define XB_SPIN_CAP (1u << 18)
__device__ __forceinline__ unsigned xb_ld(unsigned* p)              { return __hip_atomic_load(p, __ATOMIC_RELAXED, __HIP_MEMORY_SCOPE_AGENT); }
__device__ __forceinline__ unsigned xb_add(unsigned* p, unsigned v) { return __hip_atomic_fetch_add(p, v, __ATOMIC_RELAXED, __HIP_MEMORY_SCOPE_AGENT); }
__device__ __forceinline__ unsigned xb_xcc_id() { return (unsigned)__builtin_amdgcn_s_getreg((3 << 11) | 20) & 0xFu; }
#define XB_SPIN(cond, bar) do { unsigned _sp = 0; while (cond) { __builtin_amdgcn_s_sleep(1); \
    if ((++_sp & 255u) == 0u) { if (xb_ld(&(bar)[XB_TMO])) break; if (_sp > XB_SPIN_CAP) { atomicAdd(&(bar)[XB_TMO], 1u); break; } } } } while (0)
struct XcdBarrier { unsigned* bar; unsigned x; volatile LAS unsigned* st; };
__device__ __forceinline__ XcdBarrier xcd_barrier_post(unsigned* bar, volatile LAS unsigned* st) {
    XcdBarrier b; b.bar = bar; b.x = xb_xcc_id(); b.st = st;
    if (threadIdx.x == 0) (void)xb_add(&bar[XB_XCNT(b.x)], 1u);
    return b;
}
__device__ __forceinline__ void xcd_barrier_complete(unsigned* bar, unsigned x, unsigned& nloc, unsigned& nx) {
    const unsigned G = gridDim.x * gridDim.y * gridDim.z;
    unsigned sum, cnt, mine, sp = 0u;
    for (;;) {
        sum = 0u; cnt = 0u; mine = 0u;
#pragma unroll
        for (unsigned j = 0; j < 16; ++j) { const unsigned c = xb_ld(&bar[XB_XCNT(j)]); sum += c; cnt += (c > 0u) ? 1u : 0u; mine = (j == x) ? c : mine; }
        if (sum == G) break;
        __builtin_amdgcn_s_sleep(1);
        if ((++sp & 255u) == 0u) { if (xb_ld(&bar[XB_TMO])) break; if (sp > XB_SPIN_CAP) { atomicAdd(&bar[XB_TMO], 1u); break; } }
    }
    nloc = mine > 0u ? mine : 1u; nx = cnt > 0u ? cnt : 1u;
}
__device__ __forceinline__ void xcd_barrier(const XcdBarrier& b) {
    asm volatile("s_waitcnt vmcnt(0)" ::: "memory");
    __syncthreads();
    if (threadIdx.x == 0) {
        unsigned* bar = b.bar;
        __builtin_amdgcn_s_waitcnt(0);
        unsigned nloc = b.st[0], nx = b.st[1];
        if (nloc == 0u) { xcd_barrier_complete(bar, b.x, nloc, nx); b.st[0] = nloc; b.st[1] = nx; }
        const unsigned old = xb_add(&bar[XB_XSUB(b.x)], 1u);
        const unsigned gen = old / nloc;
        if (old + 1u == (gen + 1u) * nloc) {
            __builtin_amdgcn_fence(__ATOMIC_RELEASE, "agent");
            asm volatile("s_waitcnt vmcnt(0)" ::: "memory");
            const unsigned og = xb_add(&bar[XB_TOP], 1u);
            const unsigned tg = og / nx;
            if (og + 1u == (tg + 1u) * nx) xb_add(&bar[XB_TOPGEN], 1u);
            else XB_SPIN(xb_ld(&bar[XB_TOPGEN]) == tg, bar);
            __builtin_amdgcn_fence(__ATOMIC_ACQUIRE, "agent");
            xb_add(&bar[XB_XGEN(b.x)], 1u);
            asm volatile("s_waitcnt vmcnt(0)" ::: "memory");
        } else {
            XB_SPIN(xb_ld(&bar[XB_XGEN(b.x)]) == gen, bar);
            __builtin_amdgcn_fence(__ATOMIC_ACQUIRE, "agent");
            asm volatile("s_waitcnt vmcnt(0)" ::: "memory");
        }
    }
    __syncthreads();
}

struct Args { const void* in[18]; float* out; unsigned char* ws; int ph_lo, ph_hi, dry, pad; };
enum { I_X = 0, I_C, I_POS, I_ADAW, I_ADAB, I_NMIX, I_NFFN, I_ABWIN, I_SGUW, I_SGUB, I_ABWOUT, I_CWIN, I_CW, I_CWOUT, I_FG, I_FU, I_FD, I_FNORM };

__device__ __forceinline__ float wave_sum(float v) {
    v += swz_xor<1>(v); v += swz_xor<2>(v); v += swz_xor<4>(v); v += swz_xor<8>(v); v += swz_xor<16>(v);
    auto rr = __builtin_amdgcn_permlane32_swap(__float_as_uint(v), __float_as_uint(v), false, false);
    return __uint_as_float(rr[0]) + __uint_as_float(rr[1]);
}
__device__ __forceinline__ unsigned pk2(float lo, float hi) { return cvt_pk_bf16(lo, hi); }

__device__ __forceinline__ void p0_transpose_item(const float* W, int ldn, int col0, int k0, bf16* WT, int K, int drow0, bool perm, LAS float* scr, int lane, const float* shv, i64* biasr, int bN) {
    float wv[32];
#pragma unroll
    for (int i = 0; i < 32; ++i) { const int kk = 2 * i + (lane >> 5); wv[i] = W[(size_t)(k0 + kk) * ldn + col0 + (lane & 31)]; }
#pragma unroll
    for (int i = 0; i < 32; ++i) { const int kk = 2 * i + (lane >> 5); scr[kk * 33 + (lane & 31)] = wv[i]; }
    if (biasr) {
        LAS float* scs = scr + 64 * 33;
#pragma unroll
        for (int b = 0; b < 4; ++b) scs[b * 64 + lane] = shv[(size_t)b * 6 * DM + k0 + lane];
    }
    LDS_WAIT(); asm volatile("" ::: "memory");
    if (biasr) {
        const LAS float* scs = scr + 64 * 33;
        const int rho = lane & 31, kh = lane >> 5, src = perm ? pg8::perm32(rho) : rho;
        float a0 = 0.f, a1 = 0.f, a2 = 0.f, a3 = 0.f;
#pragma unroll 8
        for (int k2 = 0; k2 < 32; ++k2) { const int kk = 32 * kh + k2; const float w = scr[kk * 33 + src];
            a0 += w * scs[kk]; a1 += w * scs[64 + kk]; a2 += w * scs[128 + kk]; a3 += w * scs[192 + kk]; }
        a0 = half_sum(a0); a1 = half_sum(a1); a2 = half_sum(a2); a3 = half_sum(a3);
        if (lane < 32) { i64* bp = biasr + rho;
            __hip_atomic_fetch_add(bp, (i64)(a0 * BIAS_SCALE), __ATOMIC_RELAXED, __HIP_MEMORY_SCOPE_AGENT); __hip_atomic_fetch_add(bp + bN, (i64)(a1 * BIAS_SCALE), __ATOMIC_RELAXED, __HIP_MEMORY_SCOPE_AGENT);
            __hip_atomic_fetch_add(bp + 2 * bN, (i64)(a2 * BIAS_SCALE), __ATOMIC_RELAXED, __HIP_MEMORY_SCOPE_AGENT); __hip_atomic_fetch_add(bp + 3 * bN, (i64)(a3 * BIAS_SCALE), __ATOMIC_RELAXED, __HIP_MEMORY_SCOPE_AGENT); }
    }
    const int c = lane & 7;
#pragma unroll
    for (int j = 0; j < 4; ++j) { const int rho = (lane >> 3) + 8 * j; const int src = perm ? pg8::perm32(rho) : rho; const LAS float* s = scr + (8 * c) * 33 + src;
        u32x4 o; o.x = pk2(s[0 * 33], s[1 * 33]); o.y = pk2(s[2 * 33], s[3 * 33]); o.z = pk2(s[4 * 33], s[5 * 33]); o.w = pk2(s[6 * 33], s[7 * 33]);
        *(GAS u32x4*)(WT + (size_t)(drow0 + rho) * K + k0 + 8 * c) = o; }
    LDS_WAIT(); asm volatile("" ::: "memory");
}

__device__ __forceinline__ void prenorm_rows(int gw, int lane, const float* xin, bf16* XB, bf16* outp, const float* A, int bstride, u64* ssq) {
    const int r0 = gw * 16, b = r0 / SEQ;
    f32x4 av[8];
#pragma unroll
    for (int j = 0; j < 8; ++j) av[j] = *(const f32x4*)(A + (size_t)b * bstride + 4 * (lane + 64 * j));
    for (int r = 0; r < 16; ++r) { const size_t row = (size_t)(r0 + r);
        const f32x4* xr = (const f32x4*)(xin + row * DM) + lane;
        f32x4 v[8]; float ss = 0.f;
#pragma unroll
        for (int j = 0; j < 8; ++j) v[j] = xr[64 * j];
#pragma unroll
        for (int j = 0; j < 8; ++j) { u32x2 w; w.x = pk2(v[j].x, v[j].y); w.y = pk2(v[j].z, v[j].w); *((u32x2*)(XB + row * DM) + lane + 64 * j) = w;
            v[j] = (f32x4){bf_lo(w.x), bf_hi(w.x), bf_lo(w.y), bf_hi(w.y)}; ss += (v[j].x * v[j].x + v[j].y * v[j].y) + (v[j].z * v[j].z + v[j].w * v[j].w); }
        ss = wave_sum(ss);
        if (lane == 0) ssq[row] = (u64)(ss * SSQ_SCALE + 0.5f);
#pragma unroll
        for (int j = 0; j < 8; ++j) { const f32x4 o = v[j] * av[j]; u32x2 w; w.x = pk2(o.x, o.y); w.y = pk2(o.z, o.w); *((u32x2*)(outp + row * DM) + lane + 64 * j) = w; }
    }
}
__device__ __forceinline__ void final_rows(int gw, int lane, const bf16* XB, float* outp, const float* A, const u64* ssq) {
    f32x4 av[4][2];
#pragma unroll
    for (int j = 0; j < 4; ++j) { av[j][0] = *(const f32x4*)(A + 8 * (lane + 64 * j)); av[j][1] = *(const f32x4*)(A + 8 * (lane + 64 * j) + 4); }
    for (int rb = 0; rb < 16; rb += 4) {
        u32x4 xq[4][4]; u64 sq[4];
#pragma unroll
        for (int r = 0; r < 4; ++r) { const size_t row = (size_t)gw * 16 + rb + r; sq[r] = ssq[row];
#pragma unroll
            for (int j = 0; j < 4; ++j) xq[r][j] = *((const u32x4*)(XB + row * DM) + lane + 64 * j); }
#pragma unroll
        for (int r = 0; r < 4; ++r) { const size_t row = (size_t)gw * 16 + rb + r; const float rstd = 1.0f / sqrtf((float)sq[r] * (1.0f / (SSQ_SCALE * DM)) + EPS);
#pragma unroll
            for (int j = 0; j < 4; ++j) { const u32x4 xi = xq[r][j];
                float* op = outp + row * DM + 8 * (lane + 64 * j);
                *(f32x4*)op = (f32x4){bf_lo(xi.x), bf_hi(xi.x), bf_lo(xi.y), bf_hi(xi.y)} * rstd * av[j][0];
                *(f32x4*)(op + 4) = (f32x4){bf_lo(xi.z), bf_hi(xi.z), bf_lo(xi.w), bf_hi(xi.w)} * rstd * av[j][1]; } }
    }
}


typedef __attribute__((address_space(4))) const char kargc;
__device__ __forceinline__ const void* karg(int idx) {
    asm volatile("" : "+s"(idx));
    kargc* kp = (kargc*)__builtin_amdgcn_kernarg_segment_ptr();
    return *(const void* __attribute__((address_space(4))) const*)(kp + (size_t)idx * 8);
}
#define KIN(i) karg(i)
#define KOUT() ((float*)karg(18))
#define KWS() ((unsigned char*)karg(19))

__device__ __forceinline__ att::BlockRef att_mkref(int L, int G) {
    const int rnd = L / G, w = L - rnd * G; const int xx = (w + rnd) & 31; const int bh = (rnd / 3) * 8 + (w >> 5), br = rnd % 3;
    const int dsh = 2 * br, nqb = 32 >> dsh;
    const int rr = xx / nqb, qb = xx % nqb, b = bh / NAH, h = bh % NAH;
    att::BlockRef R; R.tok0 = b * SEQ + rr; R.h = h; R.br = br; R.P0 = qb * att::QB; R.dil = 1 << dsh;
    return R;
}

__global__ void __launch_bounds__(NWAVES * 64, 2) mega_fwd(Args args) {
    extern __shared__ __attribute__((aligned(16))) unsigned char lds[];
    LAS unsigned char* ldsl = (LAS unsigned char*)lds;
    volatile LAS unsigned* MISC = (volatile LAS unsigned*)(ldsl + MISC_OFF);
    const int tid0 = threadIdx.x, wave = __builtin_amdgcn_readfirstlane(tid0 >> 6);
#define OPAQUE_TID() int tid = threadIdx.x; asm volatile("" : "+v"(tid)); const int lane = tid & 63; (void)lane
    const int G = gridDim.x; const int bx = blockIdx.x; const int vcu = (G % 8 == 0) ? (bx % 8) * (G / 8) + bx / 8 : bx;
    const int gw = vcu * NWAVES + wave, NGW = G * NWAVES;
    gu32* ctl = (gu32*)(args.ws + WS_CTL);
    for (int u = tid0; u < (LDS_BYTES - LDSCTL_OFF) / 4; u += NWAVES * 64) ((LAS unsigned*)(ldsl + LDSCTL_OFF))[u] = 0u;
    __syncthreads();
    XcdBarrier bar; bar.bar = (unsigned*)(ctl + CW_BAR); bar.x = 0; bar.st = nullptr;
    if (!MK_PER_PHASE) bar = xcd_barrier_post((unsigned*)(ctl + CW_BAR), MISC + 8);
    const int lo = args.ph_lo, hi = args.ph_hi;
#define IN(k) (lo <= (k) && (k) < hi)
#define SEAM(k) do { if (!MK_PER_PHASE && (k) + 1 < hi) xcd_barrier(bar); } while (0)

    if (IN(0)) { OPAQUE_TID(); unsigned char* ws = KWS(); float* PART = (float*)(ws + WS_PART);
        { const float* cin = (const float*)KIN(I_C); const float* adaw = (const float*)KIN(I_ADAW);
          for (int it = gw; it < 4 * 32 * 48; it += NGW) { const int ng = it % 48, kc = (it / 48) % 32, l = it / (48 * 32);
              const int k0 = 64 * kc, n0 = 256 * ng;
              float ca[4];
#pragma unroll
              for (int b = 0; b < 4; ++b) ca[b] = silu_f(cin[b * DM + k0 + lane]);
              f32x4 ac[4];
#pragma unroll
              for (int b = 0; b < 4; ++b) ac[b] = (f32x4){0.f, 0.f, 0.f, 0.f};
              const float* wp = adaw + ((size_t)l * DM + k0) * (6 * DM) + n0 + 4 * lane;
#pragma unroll 16
              for (int kk = 0; kk < 64; ++kk) { const f32x4 w = *(const f32x4*)(wp + (size_t)kk * (6 * DM));
#pragma unroll
                  for (int b = 0; b < 4; ++b) { const float s = __uint_as_float(__builtin_amdgcn_readlane(__float_as_uint(ca[b]), kk)); ac[b] += w * s; } }
#pragma unroll
              for (int b = 0; b < 4; ++b) *(f32x4*)(PART + ((size_t)((kc * 4 + l) * 4 + b)) * (6 * DM) + n0 + 4 * lane) = ac[b];
          } }
        { const int* pos = (const int*)KIN(I_POS); float* ROPE = (float*)(ws + WS_ROPE);
          for (int e = vcu * 512 + tid; e < MTOK * 16; e += G * 512) { const int row = e >> 4, i = e & 15;
              const double invf = exp2(-(double)i * (18.931568569324174 / 16.0));
              const double rev = (double)pos[row] * invf * 0.15915494309189535;
              const float fr = (float)(rev - floor(rev));
              ROPE[(size_t)row * 32 + i] = __builtin_amdgcn_cosf(fr); ROPE[(size_t)row * 32 + 16 + i] = __builtin_amdgcn_sinf(fr); } }
        { const float* sw = (const float*)KIN(I_SGUW); bf16* SGUW = (bf16*)(ws + WS_SGUW);
          for (int e = vcu * 512 + tid; e < 2 * 4 * 128 * 128; e += G * 512) { const int s = e & 127, t = (e >> 7) & 127;
              SGUW[e] = (bf16)(cvt_pk_bf16(s <= t ? sw[e] : 0.f, 0.f) & 0xffffu); } }
    }
    SEAM(0);
    if (IN(1)) { OPAQUE_TID(); unsigned char* ws = KWS(); float* PART = (float*)(ws + WS_PART); float* MODV = (float*)(ws + WS_MODV);
        const float* adab = (const float*)KIN(I_ADAB); const float* nmix = (const float*)KIN(I_NMIX); const float* nffn = (const float*)KIN(I_NFFN);
        for (int e = vcu * 512 + tid; e < 6 * 4 * 4 * DM; e += G * 512) { const int col = e % DM, b = (e / DM) % 4, l = (e / (4 * DM)) % 4, ch = e / (16 * DM);
            float pv[32];
#pragma unroll
            for (int kc = 0; kc < 32; ++kc) pv[kc] = PART[((size_t)((kc * 4 + l) * 4 + b)) * (6 * DM) + ch * DM + col];
            float sm = adab[l * 6 * DM + ch * DM + col];
#pragma unroll
            for (int kc = 0; kc < 32; ++kc) sm += pv[kc];
            const int slot = (ch == 0) ? 1 : (ch == 1) ? 0 : (ch == 3) ? 4 : (ch == 4) ? 3 : ch;
            float val = sm;
            if (ch == 1) val = nmix[l * DM + col] * (1.0f + sm);
            if (ch == 4) val = nffn[l * DM + col] * (1.0f + sm);
            MODV[((size_t)(l * 4 + b) * 6 + slot) * DM + col] = val; }
    }
    SEAM(1);
    if (IN(2)) { OPAQUE_TID(); unsigned char* ws = KWS(); const float* MODVc = (const float*)(ws + WS_MODV); i64* BIASR = (i64*)(ws + WS_BIASR);
        { LAS float* scr = (LAS float*)(ldsl + RING_OFF + wave * 16384);
          constexpr int C0 = 2 * 176 * 32, C1 = 2 * 64 * 32, C2 = 2 * 192 * 32, C3 = 2 * 64 * 32, C4 = 4 * 352 * 32, C5 = 4 * 64 * 88;
          constexpr int NIT = C0 + C1 + C2 + C3 + C4 + C5;
          for (int it = gw; it < NIT; it += NGW) { int r = it;
              if (r < C0) { const int i = r / (176 * 32), rem = r % (176 * 32), kb = rem / 176, gd = rem % 176;
                  p0_transpose_item((const float*)KIN(I_ABWIN) + (size_t)i * DM * MIXIN, MIXIN, 32 * gd, 64 * kb, (bf16*)(ws + WS_WINE + i * SZ_WINE), DM, 32 * gd, gd >= 96, scr, lane, MODVc + ((size_t)(2 * i) * 4 * 6 + 1) * DM, BIASR + BIAS_INE + (size_t)i * 4 * MIXIN + 32 * gd, MIXIN); continue; } r -= C0;
              if (r < C1) { const int i = r / (64 * 32), rem = r % (64 * 32), kb = rem / 64, gd = rem % 64;
                  p0_transpose_item((const float*)KIN(I_ABWOUT) + (size_t)i * DM * DM, DM, 32 * gd, 64 * kb, (bf16*)(ws + WS_WOUTE + i * SZ_WSQ), DM, 32 * gd, true, scr, lane, nullptr, nullptr, 0); continue; } r -= C1;
              if (r < C2) { const int i = r / (192 * 32), rem = r % (192 * 32), kb = rem / 192, gd = rem % 192; const int t = gd >> 3, w = gd & 7;
                  const int col0 = (t < 8) ? 32 * gd : ((w < 4) ? 2048 + 128 * (t - 8) + 32 * w : 4096 + 128 * (t - 8) + 32 * (w - 4));
                  p0_transpose_item((const float*)KIN(I_CWIN) + (size_t)i * DM * CIN, CIN, col0, 64 * kb, (bf16*)(ws + WS_WINO + i * SZ_WINO), DM, 32 * gd, true, scr, lane, MODVc + ((size_t)(2 * i + 1) * 4 * 6 + 1) * DM, BIASR + BIAS_INO + (size_t)i * 4 * CIN + 32 * gd, CIN); continue; } r -= C2;
              if (r < C3) { const int i = r / (64 * 32), rem = r % (64 * 32), kb = rem / 64, gd = rem % 64;
                  p0_transpose_item((const float*)KIN(I_CWOUT) + (size_t)i * DM * DM, DM, 32 * gd, 64 * kb, (bf16*)(ws + WS_WOUTO + i * SZ_WSQ), DM, 32 * gd, true, scr, lane, nullptr, nullptr, 0); continue; } r -= C3;
              if (r < C4) { const int l = r / (352 * 32), rem = r % (352 * 32), kb = rem / 352, gd = rem % 352; const int t = gd >> 3, w = gd & 7;
                  const float* src = (const float*)KIN((w < 4) ? I_FG : I_FU);
                  p0_transpose_item(src + (size_t)l * DM * DFF, DFF, 128 * t + 32 * (w & 3), 64 * kb, (bf16*)(ws + WS_WGU + l * SZ_WGU), DM, 32 * gd, true, scr, lane, MODVc + ((size_t)l * 4 * 6 + 4) * DM, BIASR + BIAS_GU + (size_t)l * 4 * NGU + 32 * gd, NGU); continue; } r -= C4;
              { const int l = r / (64 * 88), rem = r % (64 * 88), kb = rem / 64, gd = rem % 64;
                  p0_transpose_item((const float*)KIN(I_FD) + (size_t)l * DFF * DM, DM, 32 * gd, 64 * kb, (bf16*)(ws + WS_WD + l * SZ_WD), DFF, 32 * gd, true, scr, lane, nullptr, nullptr, 0); }
          } }
        prenorm_rows(gw, lane, (const float*)KIN(I_X), (bf16*)(ws + WS_XB), (bf16*)(ws + WS_H), MODVc, 6 * DM, (u64*)(ws + WS_SSQ) + (size_t)8 * MTOK);
    }
    SEAM(2);

    for (int layer = 0; layer < 4; ++layer) {
        const int pb = 3 + 8 * layer, li = layer >> 1; const bool even_layer = (layer & 1) == 0;
#define PH_SETUP() OPAQUE_TID(); unsigned char* ws = KWS(); const float* mv = (const float*)(ws + WS_MODV) + (size_t)layer * 4 * 6 * DM; (void)mv
        if (IN(pb + 1)) { PH_SETUP(); bf16* Hb = (bf16*)(ws + WS_H); bf16* Zb = (bf16*)(ws + WS_Z);
            if (even_layer) {
                pg8::Gemm g{Hb, (const bf16*)(ws + WS_WINE + li * SZ_WINE), MTOK, MIXIN, DM}; pg8::StaticOrder S; S.init(MTOK, MIXIN, G, bx);
                pg8::EpiInE E{Zb, (const float*)(ws + WS_ROPE), NormIn{(const u64*)(ws + WS_SSQ) + (size_t)(layer == 0 ? 8 : 2 * layer - 1) * MTOK, (const i64*)(ws + WS_BIASR) + BIAS_INE + (size_t)li * 4 * MIXIN, MIXIN, ldsl + LDSCTL_OFF + 1024}};
                pg8::gemm_phase<pg8::EpiInE, pg8::StaticOrder, true, true>(ldsl + RING_OFF, g, S, E, tid);
            } else {
                pg8::Gemm g{Hb, (const bf16*)(ws + WS_WINO + li * SZ_WINO), MTOK, CIN, DM}; pg8::StaticOrder S; S.init(MTOK, CIN, G, bx);
                pg8::EpiInO E{Zb, Zb + (size_t)MTOK * DM, NormIn{(const u64*)(ws + WS_SSQ) + (size_t)(2 * layer - 1) * MTOK, (const i64*)(ws + WS_BIASR) + BIAS_INO + (size_t)li * 4 * CIN, CIN, ldsl + LDSCTL_OFF + 1024}};
                pg8::gemm_phase<pg8::EpiInO, pg8::StaticOrder, true, true>(ldsl + RING_OFF, g, S, E, tid);
            }
        }
        SEAM(pb + 1);
        if (IN(pb + 2)) { PH_SETUP(); bf16* Zb = (bf16*)(ws + WS_Z); bf16* AO = (bf16*)(ws + WS_AO);
            if (even_layer) {
                {   constexpr int NITEM = 3 * 48 * 32; bf16* OB = (bf16*)(ws + WS_OB); float* LSE = (float*)(ws + WS_LSE);
                    const att::Bases BS{Zb, OB, LSE};
                    if (vcu < NITEM) { att::BlockRef cur = att_mkref(vcu, G); bool first = true;
                        for (int L = vcu; L < NITEM; L += G) { const att::BlockRef nxt = (L + G < NITEM) ? att_mkref(L + G, G) : cur;
                            att::swa_item(cur, nxt, BS, (char*)lds + RING_OFF, ldsl + RING_OFF, tid, first); cur = nxt; first = false; } }
                }
                VM_WAIT(); __syncthreads();
                {   const bf16* sgw = (const bf16*)(ws + WS_SGUW) + (size_t)li * 4 * 128 * 128; const float* sgb = (const float*)KIN(I_SGUB) + (size_t)li * 4 * 128;
                    char* V_lds = (char*)lds + RING_OFF;
                    int tid2 = threadIdx.x; asm volatile("" : "+v"(tid2)); const int lane2 = tid2 & 63;
                    const int r32 = lane2 & 31, hi2 = lane2 >> 5, sr = tid2 >> 4, sc = (tid2 & 15) * 8;
                    for (int s = vcu; s < 4 * 64 * 4; s += G) { const int g = s & 3, n = (s >> 2) & 63, b = s >> 8;
                        const size_t row0 = (size_t)b * SEQ + n * 128;
                        const int tb = (wave & 3) * 32, ch = wave >> 2;
                        bf16x8 vst[4];
#pragma unroll
                        for (int p = 0; p < 4; ++p) vst[p] = att::ld8(Zb + (row0 + 32 * p + sr) * ZP + 5120 + g * 128 + sc);
                        const bf16* wrow = sgw + ((size_t)g * 128 + tb + r32) * 128 + 8 * hi2;
                        bf16x8 wa[8];
#pragma unroll
                        for (int i = 0; i < 8; ++i) wa[i] = att::ld8(wrow + 16 * i);
                        const size_t rowt = row0 + tb + r32;
                        const bf16* up = Zb + rowt * ZP + 4608 + g * 128 + ch * 64 + 4 * hi2;
                        u32x2 uv[2][4];
#pragma unroll
                        for (int e = 0; e < 2; ++e)
#pragma unroll
                            for (int rg = 0; rg < 4; ++rg) uv[e][rg] = *(const u32x2*)(up + e * 32 + 8 * rg);
                        const float bias = sgb[g * 128 + tb + r32];
#pragma unroll
                        for (int p = 0; p < 4; ++p) { const int k = 32 * p + sr; *(bf16x8*)(V_lds + (k >> 6) * att::SHM_V + att::v_st(k & 63, sc)) = vst[p]; }
                        __syncthreads();
                        f32x16 o0 = {}, o1 = {};
                        const int vb0 = (int)(uintptr_t)V_lds + att::v_rd_base(lane2) + ch * 1024;
                        { bf16x8 pa0 = wa[0], pa1 = wa[1], pa2 = wa[2], pa3 = wa[3];
                          PVT_D0(0, 0, o0); PVT_D0(0, 1, o1); }
                        if (tb >= 64) { bf16x8 pa0 = wa[4], pa1 = wa[5], pa2 = wa[6], pa3 = wa[7];
                          PVT_D0(1, 0, o0); PVT_D0(1, 1, o1); }
                        bf16* op = AO + rowt * DM + AW + g * 128 + ch * 64 + 4 * hi2;
#pragma unroll
                        for (int e = 0; e < 2; ++e)
#pragma unroll
                            for (int rg = 0; rg < 4; ++rg) { const u32x2 u2 = uv[e][rg]; float m4[4];
#pragma unroll
                                for (int j = 0; j < 4; ++j) m4[j] = (e ? o1[4 * rg + j] : o0[4 * rg + j]) + bias;
                                u32x2 w; w.x = cvt_pk_bf16(bf_lo(u2.x) * m4[0], bf_hi(u2.x) * m4[1]); w.y = cvt_pk_bf16(bf_lo(u2.y) * m4[2], bf_hi(u2.y) * m4[3]);
                                *(u32x2*)(op + e * 32 + 8 * rg) = w; }
                        __syncthreads();
                    }
                }
            } else {
                const bf16* GBp = Zb; const bf16* Yp = Zb + (size_t)MTOK * DM; const float* cw = (const float*)KIN(I_CW) + (size_t)li * 3 * DM;
                const int r0 = gw * 16; const bool first = (r0 % SEQ) == 0;
                for (int cc = 0; cc < 4; ++cc) { const int col = 512 * cc + 8 * lane;
                    float w0[8], w1[8], w2[8], ym2[8], ym1[8];
#pragma unroll
                    for (int j = 0; j < 8; ++j) { w0[j] = cw[col + j]; w1[j] = cw[DM + col + j]; w2[j] = cw[2 * DM + col + j]; ym2[j] = 0.f; ym1[j] = 0.f; }
                    if (!first) { const u32x4 a = *(const u32x4*)(Yp + (size_t)(r0 - 2) * DM + col), c = *(const u32x4*)(Yp + (size_t)(r0 - 1) * DM + col);
#pragma unroll
                        for (int q = 0; q < 4; ++q) { ym2[2 * q] = bf_lo(a[q]); ym2[2 * q + 1] = bf_hi(a[q]); ym1[2 * q] = bf_lo(c[q]); ym1[2 * q + 1] = bf_hi(c[q]); } }
                    for (int rb = 0; rb < 16; rb += 8) {
                      u32x4 yq[8], gq[8];
#pragma unroll
                      for (int r = 0; r < 8; ++r) { const size_t off = (size_t)(r0 + rb + r) * DM + col; yq[r] = *(const u32x4*)(Yp + off); gq[r] = *(const u32x4*)(GBp + off); }
#pragma unroll
                      for (int r = 0; r < 8; ++r) { const size_t off = (size_t)(r0 + rb + r) * DM + col;
                        const u32x4 yv = yq[r], gv = gq[r];
                        float y0[8], gb[8], o[8];
#pragma unroll
                        for (int q = 0; q < 4; ++q) { y0[2 * q] = bf_lo(yv[q]); y0[2 * q + 1] = bf_hi(yv[q]); gb[2 * q] = bf_lo(gv[q]); gb[2 * q + 1] = bf_hi(gv[q]); }
#pragma unroll
                        for (int j = 0; j < 8; ++j) { o[j] = gb[j] * (w0[j] * ym2[j] + w1[j] * ym1[j] + w2[j] * y0[j]); ym2[j] = ym1[j]; ym1[j] = y0[j]; }
                        u32x4 w; w.x = pk2(o[0], o[1]); w.y = pk2(o[2], o[3]); w.z = pk2(o[4], o[5]); w.w = pk2(o[6], o[7]);
                        *(u32x4*)(AO + off) = w; } }
                }
            }
        }
        SEAM(pb + 2);
        if (even_layer) {
            if (IN(pb + 3)) { PH_SETUP(); bf16* AO = (bf16*)(ws + WS_AO); const bf16* OB = (const bf16*)(ws + WS_OB); const float* LSE = (const float*)(ws + WS_LSE);
                for (int rb = 0; rb < 16; rb += 2) {
                  float lq[2][3][3]; u32x4 oq[2][3][3];
#pragma unroll
                  for (int rr = 0; rr < 2; ++rr) { const size_t row = (size_t)gw * 16 + rb + rr;
#pragma unroll
                      for (int j = 0; j < 3; ++j) { const int c = lane + 64 * j, h = c >> 4;
#pragma unroll
                          for (int b3 = 0; b3 < 3; ++b3) { lq[rr][j][b3] = LSE[(size_t)b3 * MTOK * NAH + row * NAH + h]; oq[rr][j][b3] = *(const u32x4*)(OB + (size_t)b3 * MTOK * AW + row * AW + 8 * c); } } }
#pragma unroll
                  for (int rr = 0; rr < 2; ++rr) { const size_t row = (size_t)gw * 16 + rb + rr;
#pragma unroll
                    for (int j = 0; j < 3; ++j) { const int c = lane + 64 * j;
                        const float l0 = lq[rr][j][0], l1 = lq[rr][j][1], l2 = lq[rr][j][2];
                        const float mx = fmaxf(l0, fmaxf(l1, l2)); float e0 = fast_exp(l0 - mx), e1 = fast_exp(l1 - mx), e2 = fast_exp(l2 - mx);
                        const float inv = 1.0f / (e0 + e1 + e2); e0 *= inv; e1 *= inv; e2 *= inv;
                        const u32x4 a = oq[rr][j][0], bq = oq[rr][j][1], cq = oq[rr][j][2];
                        u32x4 w;
#pragma unroll
                        for (int q = 0; q < 4; ++q) w[q] = pk2(e0 * bf_lo(a[q]) + e1 * bf_lo(bq[q]) + e2 * bf_lo(cq[q]), e0 * bf_hi(a[q]) + e1 * bf_hi(bq[q]) + e2 * bf_hi(cq[q]));
                        *(u32x4*)(AO + row * DM + 8 * c) = w; } } }
            }
            SEAM(pb + 3);
        }
        if (IN(pb + 4)) { PH_SETUP(); const bf16* AO = (const bf16*)(ws + WS_AO); bf16* xb = (bf16*)(ws + WS_XB); bf16* xw = args.dry ? (bf16*)(ws + WS_OB) : xb;
            const bf16* wo = even_layer ? (const bf16*)(ws + WS_WOUTE + li * SZ_WSQ) : (const bf16*)(ws + WS_WOUTO + li * SZ_WSQ);
            pg8::Gemm g{AO, wo, MTOK, DM, DM}; pg8::StaticOrder S; S.init(MTOK, DM, G, bx);
            pg8::EpiRes E{xb, xw, mv + 2 * DM, 6 * DM, (bf16*)(ws + WS_H), mv + 3 * DM, 6 * DM, (u64*)(ws + WS_SSQ) + (size_t)(2 * layer) * MTOK, ldsl + LDSCTL_OFF + 1024};
            pg8::gemm_phase<pg8::EpiRes, pg8::StaticOrder, true, true>(ldsl + RING_OFF, g, S, E, tid);
        }
        SEAM(pb + 4);
        if (IN(pb + 6)) { PH_SETUP(); const bf16* Hb = (const bf16*)(ws + WS_H); bf16* Zb = (bf16*)(ws + WS_Z);
            pg8::Gemm g{Hb, (const bf16*)(ws + WS_WGU + layer * SZ_WGU), MTOK, NGU, DM}; pg8::StaticOrder S; S.init(MTOK, NGU, G, bx);
            pg8::EpiGU E{Zb, NormIn{(const u64*)(ws + WS_SSQ) + (size_t)(2 * layer) * MTOK, (const i64*)(ws + WS_BIASR) + BIAS_GU + (size_t)layer * 4 * NGU, NGU, ldsl + LDSCTL_OFF + 1024}};
            pg8::gemm_phase<pg8::EpiGU, pg8::StaticOrder, true, true>(ldsl + RING_OFF, g, S, E, tid);
        }
        SEAM(pb + 6);
        if (IN(pb + 7)) { PH_SETUP(); const bf16* Zb = (const bf16*)(ws + WS_Z); bf16* xb = (bf16*)(ws + WS_XB); bf16* xw = args.dry ? (bf16*)(ws + WS_OB) : xb;
            pg8::Gemm g{Zb, (const bf16*)(ws + WS_WD + layer * SZ_WD), MTOK, DM, DFF}; pg8::StaticOrder S; S.init(MTOK, DM, G, bx);
            pg8::EpiRes E{xb, xw, mv + 5 * DM, 6 * DM, layer < 3 ? (bf16*)(ws + WS_H) : (bf16*)nullptr, mv + 4 * 6 * DM, 6 * DM, (u64*)(ws + WS_SSQ) + (size_t)(2 * layer + 1) * MTOK, ldsl + LDSCTL_OFF + 1024};
            pg8::gemm_phase<pg8::EpiRes, pg8::StaticOrder, true, true>(ldsl + RING_OFF, g, S, E, tid);
        }
        SEAM(pb + 7);
    }
    if (IN(35)) { OPAQUE_TID(); unsigned char* ws = KWS(); final_rows(gw, lane, (const bf16*)(ws + WS_XB), KOUT(), (const float*)KIN(I_FNORM), (const u64*)(ws + WS_SSQ) + (size_t)7 * MTOK); }
#undef IN
#undef SEAM
}

extern "C" void kernel_launch(void* const* d_in, const int* in_sizes, int n_in, void* d_out, int out_size, void* d_ws, size_t ws_size, hipStream_t stream) {
    static int grid = 0;
    if (grid == 0) {
        if (n_in != 18 || out_size != MTOK * DM || ws_size < WS_END) { fprintf(stderr, "kernel_launch: unexpected shapes (n_in %d, out %d, ws %zu; need ws >= %zu)\n", n_in, out_size, ws_size, (size_t)WS_END); grid = -1; return; }
        int dev = 0, cus = 0, per_cu = 0;
        if (hipGetDevice(&dev) != hipSuccess || hipDeviceGetAttribute(&cus, hipDeviceAttributeMultiprocessorCount, dev) != hipSuccess) { grid = -1; return; }
        if (hipFuncSetAttribute((const void*)mega_fwd, hipFuncAttributeMaxDynamicSharedMemorySize, LDS_BYTES) != hipSuccess) { fprintf(stderr, "kernel_launch: hipFuncSetAttribute failed\n"); grid = -1; return; }
        if (hipOccupancyMaxActiveBlocksPerMultiprocessor(&per_cu, (const void*)mega_fwd, NWAVES * 64, LDS_BYTES) != hipSuccess || per_cu < 1)
            fprintf(stderr, "kernel_launch: note: occupancy query reports %d workgroups per CU\n", per_cu);
        (void)hipGetLastError();
        grid = cus;
        if (grid != 256) fprintf(stderr, "kernel_launch: %d CUs (built for 256)\n", grid);
    }
    if (grid < 0) return;
    (void)in_sizes;
    if (hipMemsetAsync((char*)d_ws + WS_CTL, 0, CTL_ZERO_BYTES, stream) != hipSuccess) return;
    Args a{};
    for (int i = 0; i < 18; ++i) a.in[i] = d_in[i];
    a.out = (float*)d_out; a.ws = (unsigned char*)d_ws;
#if MK_PER_PHASE
    for (int p = 0; p < 36; ++p) { if (p >= 3 && p < 35) { const int k = (p - 3) % 8, l = (p - 3) / 8; if (k == 0 || k == 5 || (k == 3 && (l & 1))) continue; }
        a.ph_lo = p; a.ph_hi = p + 1; hipLaunchKernelGGL(mega_fwd, dim3(grid), dim3(NWAVES * 64), LDS_BYTES, stream, a); }
#else
    a.ph_lo = 0; a.ph_hi = 36;
    hipLaunchKernelGGL(mega_fwd, dim3(grid), dim3(NWAVES * 64), LDS_BYTES, stream, a);
    for (int r = 0; r < PROBE_REPS; ++r) { (void)hipMemsetAsync((char*)d_ws + WS_CTL, 0, CTL_ZERO_BYTES, stream);
        a.ph_lo = PROBE_LO; a.ph_hi = PROBE_HI; a.dry = PROBE_DRY; hipLaunchKernelGGL(mega_fwd, dim3(grid), dim3(NWAVES * 64), LDS_BYTES, stream, a); }
#endif
}
```

```cpp
#include <hip/hip_runtime.h>
#include <cstdio>
#include <cstdint>

#ifndef PROBE_REPS
#define PROBE_REPS 0
#define PROBE_LO 0
#define PROBE_HI 0
#define PROBE_DRY 0
#endif
#ifndef MK_PER_PHASE
#define MK_PER_PHASE 0
#endif

constexpr int BATCH = 4, SEQ = 8192, DM = 2048, MTOK = BATCH * SEQ, DFF = 5632, HD = 128, NAH = 12, AW = 1536, SW = 512, MIXIN = 5632, CIN = 6144, NGU = 2 * DFF;
constexpr int ZP = 5632;
constexpr float EPS = 1e-6f;

typedef unsigned short bf16;
typedef short bf16x8 __attribute__((ext_vector_type(8)));
typedef short s16x4 __attribute__((ext_vector_type(4)));
typedef float f32x4 __attribute__((ext_vector_type(4)));
typedef float f32x16 __attribute__((ext_vector_type(16)));
typedef float f32x2 __attribute__((ext_vector_type(2)));
typedef unsigned u32x4 __attribute__((ext_vector_type(4)));
typedef unsigned u32x2 __attribute__((ext_vector_type(2)));
#define LAS __attribute__((address_space(3)))
#define GAS __attribute__((address_space(1)))

__device__ __forceinline__ unsigned cvt_pk_bf16(float lo, float hi) { unsigned r; asm volatile("v_cvt_pk_bf16_f32 %0, %1, %2" : "=v"(r) : "v"(lo), "v"(hi)); return r; }
__device__ __forceinline__ float bf_lo(unsigned w) { return __uint_as_float(w << 16); }
__device__ __forceinline__ float bf_hi(unsigned w) { return __uint_as_float(w & 0xffff0000u); }
__device__ __forceinline__ float fast_exp(float x) { return __builtin_amdgcn_exp2f(x * 1.4426950408889634f); }
__device__ __forceinline__ float gelu_tanh(float x) {
    const float t = x * (1.0f + 0.044715f * x * x) * (-2.0f * 0.7978845608028654f * 1.4426950408889634f);
    return x * __builtin_amdgcn_rcpf(1.0f + __builtin_amdgcn_exp2f(t));
}
__device__ __forceinline__ float silu_f(float x) { return x * __builtin_amdgcn_rcpf(1.0f + __builtin_amdgcn_exp2f(x * -1.4426950408889634f)); }

template <int O> __device__ __forceinline__ float swz_xor(float v) { return __int_as_float(__builtin_amdgcn_ds_swizzle(__float_as_int(v), (O << 10) | 0x1f)); }
__device__ __forceinline__ float xor1(float v) { return __int_as_float(__builtin_amdgcn_update_dpp(0, __float_as_int(v), 0xB1, 0xf, 0xf, true)); }
__device__ __forceinline__ float half_sum(float v) { auto rr = __builtin_amdgcn_permlane32_swap(__float_as_uint(v), __float_as_uint(v), false, false); return __uint_as_float(rr[0]) + __uint_as_float(rr[1]); }
typedef unsigned u64; typedef int i64;
constexpr float SSQ_SCALE = 1024.0f, BIAS_SCALE = 1048576.0f;
struct NormIn { const u64* ssq; const i64* bias; int N; LAS unsigned char* stg;
    __device__ __forceinline__ void stage(int pm, int pn, int lane) const {
        __builtin_amdgcn_global_load_lds((const unsigned*)(ssq + (size_t)pm * 256 + lane * 4), (LAS unsigned*)stg, 16, 0, 0);
        __builtin_amdgcn_global_load_lds((const unsigned*)(bias + (size_t)(pm >> 5) * N + pn * 256 + lane * 4), (LAS unsigned*)(stg + 1024), 16, 0, 0); }
    __device__ __forceinline__ float rs(int rowl) const;
    __device__ __forceinline__ f32x4 bias4l(int coll) const;
};
__device__ __forceinline__ float rs_of(const u64* ssq, int row) { return __builtin_amdgcn_rsqf((float)ssq[row] * (1.0f / (SSQ_SCALE * DM)) + EPS); }
typedef int i32x4 __attribute__((ext_vector_type(4)));
__device__ __forceinline__ f32x4 bias4(const i64* p) { const i32x4 v = *(const i32x4*)p; return (f32x4){(float)v.x, (float)v.y, (float)v.z, (float)v.w} * (1.0f / BIAS_SCALE); }
__device__ __forceinline__ float NormIn::rs(int rowl) const { return __builtin_amdgcn_rsqf((float)((const LAS u64*)stg)[rowl] * (1.0f / (SSQ_SCALE * DM)) + EPS); }
__device__ __forceinline__ f32x4 NormIn::bias4l(int coll) const { const i32x4 v = *(const LAS i32x4*)(stg + 1024 + coll * 4); return (f32x4){(float)v.x, (float)v.y, (float)v.z, (float)v.w} * (1.0f / BIAS_SCALE); }
__device__ __forceinline__ void ssq_add(u64* p, float v) { __hip_atomic_fetch_add(p, (u64)(v * SSQ_SCALE + 0.5f), __ATOMIC_RELAXED, __HIP_MEMORY_SCOPE_AGENT); }

namespace pg8 {
constexpr int BM = 256, BK = 64, HALF = 128, HTB = HALF * BK * 2, STAGE_BYTES = 8 * HTB, NXCD = 8, WGM = 4;
__host__ __device__ __forceinline__ int lds_byte(int r, int c) { const int st = (r >> 4) * 2 + (c >> 5), rr = r & 15, cc = c & 31, ob = rr * 64 + cc * 2; return st * 1024 + (ob ^ (((ob >> 9) & 1) << 5)); }
__host__ __device__ __forceinline__ void stage_rc(int b, int& R, int& C) { const int st = b / 1024, sb = b % 1024, swz = sb ^ (((sb >> 9) & 1) << 5); R = (st >> 1) * 16 + swz / 64; C = (st & 1) * 32 + (swz % 64) / 2; }
__host__ __device__ __forceinline__ int perm32(int rho) { const int n = rho >> 4, i = rho & 15; return 8 * (i >> 2) + 4 * n + (i & 3); }

struct Unit { int pm, pn; };
struct Gemm { const bf16* A; const bf16* Bt; int M, N, K; };

struct StaticOrder {
    int nM, nN, nwg, G, c;
    __host__ __device__ void init(int M, int N, int G_, int c_) { nM = M / BM; nN = N / BM; nwg = nM * nN; G = G_; c = c_; }
    __host__ __device__ bool next(int i, Unit& u) const {
        const long L = (long)i * G + c; if (L >= nwg) return false;
        int wgid = (int)L; { const int q = nwg / NXCD, r = nwg % NXCD, xcd = wgid % NXCD, off = wgid / NXCD; wgid = (xcd < r ? xcd * (q + 1) : r * (q + 1) + (xcd - r) * q) + off; }
        const int nig = WGM * nN, gid = wgid / nig, fm = gid * WGM, gsz = (nM - fm) < WGM ? (nM - fm) : WGM;
        u.pm = fm + ((wgid % nig) % gsz); u.pn = (wgid % nig) / gsz; return true;
    }
    __device__ __forceinline__ void a_ready(const Unit&) const {}
    __device__ __forceinline__ void done(const Unit&) const {}
};

__device__ __forceinline__ void store8(bf16* p, f32x4 v0, f32x4 v1) {
    u32x4 w; w.x = cvt_pk_bf16(v0[0], v0[1]); w.y = cvt_pk_bf16(v0[2], v0[3]); w.z = cvt_pk_bf16(v1[0], v1[1]); w.w = cvt_pk_bf16(v1[2], v1[3]);
    *(u32x4*)p = w;
}

struct EpiInE {
    bf16* Z; const float* RT; NormIn nb;
    __device__ __forceinline__ void stage(const Unit& u, int lane) const { nb.stage(u.pm, u.pn, lane); }
    __device__ __forceinline__ void operator()(const f32x4 (&acc)[2][2][4][2], const Unit& u, int wr, int wc, int fr, int fq) const {
        const int row0 = u.pm * BM + wr * 64 + fr, col0 = u.pn * BM + wc * 32 + 8 * fq;
        f32x4 bv[2][2];
        { const int bp = wc * 32 + 4 * fq;
#pragma unroll
          for (int bj = 0; bj < 2; ++bj)
#pragma unroll
              for (int n = 0; n < 2; ++n) bv[bj][n] = nb.bias4l(bp + bj * HALF + n * 16); }
        if (u.pn < 12) {
            const bool rot = (wc == 0);
#pragma unroll
            for (int ai = 0; ai < 2; ++ai) {
                f32x4 csq[4], snq[4];
#pragma unroll
                for (int m = 0; m < 4; ++m) { csq[m] = (f32x4){1.f, 1.f, 1.f, 1.f}; snq[m] = (f32x4){0.f, 0.f, 0.f, 0.f}; }
                if (rot) {
#pragma unroll
                    for (int m = 0; m < 4; ++m) { const int row = row0 + ai * HALF + m * 16; csq[m] = *(const f32x4*)(RT + (size_t)row * 32 + 4 * fq); snq[m] = *(const f32x4*)(RT + (size_t)row * 32 + 16 + 4 * fq); } }
#pragma unroll
                for (int m = 0; m < 4; ++m) { const int row = row0 + ai * HALF + m * 16; bf16* rowp = Z + (size_t)row * ZP + col0; const float rs = nb.rs(row - u.pm * BM);
                    const f32x4 cs = csq[m], sn = snq[m];
#pragma unroll
                    for (int bj = 0; bj < 2; ++bj) { const f32x4 t1 = acc[ai][bj][m][0] * rs + bv[bj][0], t2 = acc[ai][bj][m][1] * rs + bv[bj][1];
                        store8(rowp + bj * HALF, t1 * cs - t2 * sn, t2 * cs + t1 * sn); } } }
        } else if (u.pn < 18) {
#pragma unroll
            for (int ai = 0; ai < 2; ++ai)
#pragma unroll
                for (int m = 0; m < 4; ++m) { const int row = row0 + ai * HALF + m * 16; bf16* rowp = Z + (size_t)row * ZP + col0; const float rs = nb.rs(row - u.pm * BM);
#pragma unroll
                    for (int bj = 0; bj < 2; ++bj) store8(rowp + bj * HALF, acc[ai][bj][m][0] * rs + bv[bj][0], acc[ai][bj][m][1] * rs + bv[bj][1]); }
        } else {
#pragma unroll
            for (int ai = 0; ai < 2; ++ai)
#pragma unroll
                for (int m = 0; m < 4; ++m) { const int row = row0 + ai * HALF + m * 16; bf16* rowp = Z + (size_t)row * ZP + col0; const float rs = nb.rs(row - u.pm * BM);
#pragma unroll
                    for (int bj = 0; bj < 2; ++bj) { f32x4 v0 = acc[ai][bj][m][0] * rs + bv[bj][0], v1 = acc[ai][bj][m][1] * rs + bv[bj][1];
#pragma unroll
                        for (int j = 0; j < 4; ++j) { v0[j] = gelu_tanh(v0[j]); v1[j] = gelu_tanh(v1[j]); }
                        store8(rowp + bj * HALF, v0, v1); } }
        }
    }
};
struct EpiInO {
    bf16* GB; bf16* Y; NormIn nb;
    __device__ __forceinline__ void stage(const Unit& u, int lane) const { nb.stage(u.pm, u.pn, lane); }
    __device__ __forceinline__ void operator()(const f32x4 (&acc)[2][2][4][2], const Unit& u, int wr, int wc, int fr, int fq) const {
        const int row0 = u.pm * BM + wr * 64 + fr;
        f32x4 bv[2][2];
        { const int bp = wc * 32 + 4 * fq;
#pragma unroll
          for (int bj = 0; bj < 2; ++bj)
#pragma unroll
              for (int n = 0; n < 2; ++n) bv[bj][n] = nb.bias4l(bp + bj * HALF + n * 16); }
        if (u.pn < 8) { const int col0 = u.pn * BM + wc * 32 + 8 * fq;
#pragma unroll
            for (int ai = 0; ai < 2; ++ai)
#pragma unroll
                for (int m = 0; m < 4; ++m) { const int row = row0 + ai * HALF + m * 16; bf16* rowp = GB + (size_t)row * DM + col0; const float rs = nb.rs(row - u.pm * BM);
#pragma unroll
                    for (int bj = 0; bj < 2; ++bj) store8(rowp + bj * HALF, acc[ai][bj][m][0] * rs + bv[bj][0], acc[ai][bj][m][1] * rs + bv[bj][1]); }
        } else { const int col0 = (u.pn - 8) * HALF + wc * 32 + 8 * fq;
#pragma unroll
            for (int ai = 0; ai < 2; ++ai)
#pragma unroll
                for (int m = 0; m < 4; ++m) { const int row = row0 + ai * HALF + m * 16; const float rs = nb.rs(row - u.pm * BM);
                    store8(Y + (size_t)row * DM + col0, (acc[ai][0][m][0] * rs + bv[0][0]) * (acc[ai][1][m][0] * rs + bv[1][0]), (acc[ai][0][m][1] * rs + bv[0][1]) * (acc[ai][1][m][1] * rs + bv[1][1])); }
        }
    }
};
struct EpiGU {
    bf16* Hd; NormIn nb;
    __device__ __forceinline__ void stage(const Unit& u, int lane) const { nb.stage(u.pm, u.pn, lane); }
    __device__ __forceinline__ void operator()(const f32x4 (&acc)[2][2][4][2], const Unit& u, int wr, int wc, int fr, int fq) const {
        const int row0 = u.pm * BM + wr * 64 + fr, col0 = u.pn * HALF + wc * 32 + 8 * fq;
        f32x4 bv[2][2];
        { const int bp = wc * 32 + 4 * fq;
#pragma unroll
          for (int bj = 0; bj < 2; ++bj)
#pragma unroll
              for (int n = 0; n < 2; ++n) bv[bj][n] = nb.bias4l(bp + bj * HALF + n * 16); }
#pragma unroll
        for (int ai = 0; ai < 2; ++ai)
#pragma unroll
            for (int m = 0; m < 4; ++m) { const int row = row0 + ai * HALF + m * 16; const float rs = nb.rs(row - u.pm * BM); f32x4 v0, v1;
                const f32x4 g0 = acc[ai][0][m][0] * rs + bv[0][0], g1 = acc[ai][0][m][1] * rs + bv[0][1], u0 = acc[ai][1][m][0] * rs + bv[1][0], u1 = acc[ai][1][m][1] * rs + bv[1][1];
#pragma unroll
                for (int j = 0; j < 4; ++j) { v0[j] = silu_f(g0[j]) * u0[j]; v1[j] = silu_f(g1[j]) * u1[j]; }
                store8(Hd + (size_t)row * ZP + col0, v0, v1); }
    }
};
struct EpiRes {
    const bf16* xin; bf16* xout; const float* gate; int gstride; bf16* Hn; const float* an; int astride; u64* ssq; LAS unsigned char* stg;
    __device__ __forceinline__ void stage(const Unit& u, int lane) const {
        __builtin_amdgcn_global_load_lds((const unsigned*)(gate + (size_t)(u.pm >> 5) * gstride + u.pn * BM + lane * 4), (LAS unsigned*)stg, 16, 0, 0);
        __builtin_amdgcn_global_load_lds((const unsigned*)((Hn ? an : gate) + (size_t)(u.pm >> 5) * astride + u.pn * BM + lane * 4), (LAS unsigned*)(stg + 1024), 16, 0, 0); }
    __device__ __forceinline__ void operator()(const f32x4 (&acc)[2][2][4][2], const Unit& u, int wr, int wc, int fr, int fq) const {
        const int row0 = u.pm * BM + wr * 64 + fr, col0 = u.pn * BM + wc * 32 + 8 * fq;
        const LAS unsigned char* gl = stg + (wc * 32 + 8 * fq) * 4;
        u32x4 xq[2][4][2];
#pragma unroll
        for (int ai = 0; ai < 2; ++ai)
#pragma unroll
            for (int m = 0; m < 4; ++m)
#pragma unroll
                for (int bj = 0; bj < 2; ++bj) xq[ai][m][bj] = *(const u32x4*)(xin + (size_t)(row0 + ai * HALF + m * 16) * DM + col0 + bj * HALF);
#pragma unroll
        for (int ai = 0; ai < 2; ++ai) {
#pragma unroll
            for (int m = 0; m < 4; ++m) { const int row = row0 + ai * HALF + m * 16; const size_t off = (size_t)row * DM + col0; float ps = 0.f;
#pragma unroll
                for (int bj = 0; bj < 2; ++bj) { const u32x4 xi = xq[ai][m][bj];
                    const f32x4 g0 = *(const LAS f32x4*)(gl + bj * HALF * 4), g1 = *(const LAS f32x4*)(gl + bj * HALF * 4 + 16);
                    const f32x4 x0 = (f32x4){bf_lo(xi.x), bf_hi(xi.x), bf_lo(xi.y), bf_hi(xi.y)} + g0 * acc[ai][bj][m][0];
                    const f32x4 x1 = (f32x4){bf_lo(xi.z), bf_hi(xi.z), bf_lo(xi.w), bf_hi(xi.w)} + g1 * acc[ai][bj][m][1];
                    u32x4 w; w.x = cvt_pk_bf16(x0[0], x0[1]); w.y = cvt_pk_bf16(x0[2], x0[3]); w.z = cvt_pk_bf16(x1[0], x1[1]); w.w = cvt_pk_bf16(x1[2], x1[3]);
                    *(u32x4*)(xout + off + bj * HALF) = w;
                    const f32x4 r0 = (f32x4){bf_lo(w.x), bf_hi(w.x), bf_lo(w.y), bf_hi(w.y)}, r1 = (f32x4){bf_lo(w.z), bf_hi(w.z), bf_lo(w.w), bf_hi(w.w)};
                    ps += ((r0[0] * r0[0] + r0[1] * r0[1]) + (r0[2] * r0[2] + r0[3] * r0[3])) + ((r1[0] * r1[0] + r1[1] * r1[1]) + (r1[2] * r1[2] + r1[3] * r1[3]));
                    if (Hn) { const f32x4 a0 = *(const LAS f32x4*)(gl + 1024 + bj * HALF * 4), a1 = *(const LAS f32x4*)(gl + 1024 + bj * HALF * 4 + 16); store8(Hn + off + bj * HALF, r0 * a0, r1 * a1); } }
                ps += swz_xor<16>(ps); ps = half_sum(ps); if (fq == 0) ssq_add(ssq + row, ps);
                asm volatile("" ::: "memory"); } }
    }
};

template <class Epi, class Sched, bool ALIGN_EPI = false, bool SP2 = false>
__device__ __forceinline__ void gemm_phase(LAS unsigned char* lds, const Gemm g, const Sched& S, const Epi& E, const int tid) {
    const int wid = __builtin_amdgcn_readfirstlane(tid >> 6), lane = tid & 63, wr = wid >> 2, wc = wid & 3, fr = lane & 15, fq = lane >> 4;
    const int K = g.K, nt = K / BK;
    unsigned voffA[2];
#pragma unroll
    for (int i = 0; i < 2; ++i) { int R, C; stage_rc(tid * 16 + i * 8192, R, C); voffA[i] = (unsigned)(R * K + C) * 2u; }
#define voffB voffA
    const size_t kstep = (size_t)(BK * 2);
    const size_t hstep = (size_t)HALF * K * 2;
    const size_t tstep = 2 * hstep;
    const unsigned ldsw = (unsigned)wid * 1024u;
    const int aoff = lds_byte(wr * 64 + fr, fq * 8), boff = lds_byte(wc * 32 + fr, fq * 8);
#define PG8_SA(b, h) (((b) * 2 + (h)) * HTB)
#define PG8_SB(b, h) ((4 + (b) * 2 + (h)) * HTB)
#define PG8_STAGE(bufoff, gbase, voff) do { _Pragma("unroll") for (int _i = 0; _i < 2; ++_i) \
        __builtin_amdgcn_global_load_lds((const unsigned*)((const char*)(gbase) + (voff)[_i]), (LAS unsigned*)(lds + (bufoff) + ldsw + _i * 8192), 16, 0, 0); } while (0)
#define PG8_LDA(dst, b, h) do { _Pragma("unroll") for (int m = 0; m < 4; ++m) _Pragma("unroll") for (int k = 0; k < 2; ++k) dst[m][k] = *(const LAS bf16x8*)(lds + PG8_SA(b, h) + aoff + m * 2048 + k * 1024); } while (0)
#define PG8_LDB(dst, b, h) do { _Pragma("unroll") for (int n = 0; n < 2; ++n) _Pragma("unroll") for (int k = 0; k < 2; ++k) dst[n][k] = *(const LAS bf16x8*)(lds + PG8_SB(b, h) + boff + n * 2048 + k * 1024); } while (0)
#define PG8_MMA(ai, bj, At, Bt) do { __builtin_amdgcn_s_setprio(1); _Pragma("unroll") for (int m = 0; m < 4; ++m) _Pragma("unroll") for (int n = 0; n < 2; ++n) _Pragma("unroll") for (int k = 0; k < 2; ++k) \
        acc[ai][bj][m][n] = __builtin_amdgcn_mfma_f32_16x16x32_bf16(Bt[n][k], At[m][k], acc[ai][bj][m][n], 0, 0, 0); __builtin_amdgcn_s_setprio(0); } while (0)
#define PG8_WAIT_V(n) asm volatile("s_waitcnt vmcnt(" #n ")" ::: "memory")
#define PG8_WAIT_L(n) asm volatile("s_waitcnt lgkmcnt(" #n ")" ::: "memory")
#define PG8_BAR __builtin_amdgcn_s_barrier()
#define PG8_SCHED __builtin_amdgcn_sched_barrier(0)
    Unit cur, nxt; int ui = 0;
    if (!S.next(0, cur)) return;
    f32x4 acc[2][2][4][2];
#pragma unroll
    for (int a = 0; a < 2; ++a)
#pragma unroll
        for (int b = 0; b < 2; ++b)
#pragma unroll
            for (int m = 0; m < 4; ++m)
#pragma unroll
                for (int n = 0; n < 2; ++n) acc[a][b][m][n] = (f32x4){0.f, 0.f, 0.f, 0.f};
    bf16x8 At[4][2], B0[2][2], B1[2][2];
    const char* cA = (const char*)g.A + (size_t)cur.pm * tstep; const char* cB = (const char*)g.Bt + (size_t)cur.pn * tstep;
    S.a_ready(cur);
    if constexpr (SP2) {
        PG8_STAGE(PG8_SB(0, 0), cB, voffB); PG8_STAGE(PG8_SB(0, 1), cB + hstep, voffB); PG8_STAGE(PG8_SA(0, 0), cA, voffA); PG8_STAGE(PG8_SA(0, 1), cA + hstep, voffA);
        if (wr == 1) PG8_BAR;
        PG8_WAIT_V(2); PG8_BAR;
        PG8_STAGE(PG8_SB(1, 0), cB + kstep, voffB); PG8_STAGE(PG8_SA(1, 0), cA + kstep, voffA); PG8_STAGE(PG8_SB(1, 1), cB + hstep + kstep, voffB);
        PG8_WAIT_V(6); PG8_BAR;
    } else {
        PG8_STAGE(PG8_SB(0, 0), cB, voffB); PG8_STAGE(PG8_SA(0, 0), cA, voffA); PG8_STAGE(PG8_SB(0, 1), cB + hstep, voffB); PG8_STAGE(PG8_SA(0, 1), cA + hstep, voffA);
        if (wr == 1) PG8_BAR;
        PG8_WAIT_V(4); PG8_BAR;
        PG8_STAGE(PG8_SB(1, 0), cB + kstep, voffB); PG8_STAGE(PG8_SA(1, 0), cA + kstep, voffA); PG8_STAGE(PG8_SB(1, 1), cB + hstep + kstep, voffB);
        PG8_WAIT_V(6); PG8_BAR;
    }
    for (;;) {
        const bool has_next = S.next(ui + 1, nxt);
        const char* nA = has_next ? (const char*)g.A + (size_t)nxt.pm * tstep : cA; const char* nB = has_next ? (const char*)g.Bt + (size_t)nxt.pn * tstep : cB;
        for (int t = 0; t < nt; t += 2) {
            const bool last = (t == nt - 2);
            const char* a1 = cA + (size_t)(t + 1) * kstep;
            const char* a2 = last ? nA : cA + (size_t)(t + 2) * kstep; const char* b2 = last ? nB : cB + (size_t)(t + 2) * kstep;
            const char* a3 = a2 + kstep; const char* b3 = b2 + kstep;
            if (last && has_next) S.a_ready(nxt);
            if (last && wid == 0) E.stage(cur, lane);
            if constexpr (SP2) {
            PG8_LDB(B0, 0, 0); PG8_LDB(B1, 0, 1); PG8_SCHED; PG8_LDA(At, 0, 0); PG8_STAGE(PG8_SA(1, 1), a1 + hstep, voffA);
            PG8_WAIT_V(8); PG8_WAIT_L(0); PG8_BAR; PG8_MMA(0, 0, At, B0); PG8_MMA(0, 1, At, B1); PG8_BAR; PG8_SCHED;
            PG8_LDA(At, 0, 1); PG8_STAGE(PG8_SB(0, 0), b2, voffB); PG8_STAGE(PG8_SB(0, 1), b2 + hstep, voffB); PG8_STAGE(PG8_SA(0, 0), a2, voffA);
            PG8_WAIT_V(8); PG8_WAIT_L(0); PG8_BAR; PG8_MMA(1, 0, At, B0); PG8_MMA(1, 1, At, B1); PG8_BAR; PG8_SCHED;
            PG8_LDB(B0, 1, 0); PG8_LDB(B1, 1, 1); PG8_SCHED; PG8_LDA(At, 1, 0); PG8_STAGE(PG8_SA(0, 1), a2 + hstep, voffA);
            PG8_WAIT_V(8); PG8_WAIT_L(0); PG8_BAR; PG8_MMA(0, 0, At, B0); PG8_MMA(0, 1, At, B1); PG8_BAR; PG8_SCHED;
            PG8_LDA(At, 1, 1); PG8_STAGE(PG8_SB(1, 0), b3, voffB); PG8_STAGE(PG8_SB(1, 1), b3 + hstep, voffB); PG8_STAGE(PG8_SA(1, 0), a3, voffA);
            PG8_WAIT_V(8); PG8_WAIT_L(0); PG8_BAR; PG8_MMA(1, 0, At, B0); PG8_MMA(1, 1, At, B1); PG8_BAR; PG8_SCHED;
            } else {
            PG8_LDB(B0, 0, 0); PG8_SCHED; PG8_LDA(At, 0, 0); PG8_STAGE(PG8_SA(1, 1), a1 + hstep, voffA);
            PG8_WAIT_L(8); PG8_BAR; PG8_WAIT_L(0); PG8_MMA(0, 0, At, B0); PG8_BAR; PG8_SCHED;
            PG8_LDB(B1, 0, 1); PG8_STAGE(PG8_SB(0, 0), b2, voffB);
            PG8_BAR; PG8_WAIT_L(0); PG8_MMA(0, 1, At, B1); PG8_BAR;
            PG8_LDA(At, 0, 1); PG8_STAGE(PG8_SA(0, 0), a2, voffA);
            PG8_BAR; PG8_WAIT_L(0); PG8_MMA(1, 0, At, B0); PG8_BAR; PG8_SCHED;
            PG8_STAGE(PG8_SB(0, 1), b2 + hstep, voffB);
            PG8_WAIT_V(6); PG8_BAR; PG8_MMA(1, 1, At, B1); PG8_BAR;
            PG8_LDB(B0, 1, 0); PG8_SCHED; PG8_LDA(At, 1, 0); PG8_STAGE(PG8_SA(0, 1), a2 + hstep, voffA);
            PG8_WAIT_L(8); PG8_BAR; PG8_WAIT_L(0); PG8_MMA(0, 0, At, B0); PG8_BAR; PG8_SCHED;
            PG8_LDB(B1, 1, 1); PG8_STAGE(PG8_SB(1, 0), b3, voffB);
            PG8_BAR; PG8_WAIT_L(0); PG8_MMA(0, 1, At, B1); PG8_BAR;
            PG8_LDA(At, 1, 1); PG8_STAGE(PG8_SA(1, 0), a3, voffA);
            PG8_BAR; PG8_WAIT_L(0); PG8_MMA(1, 0, At, B0); PG8_BAR; PG8_SCHED;
            PG8_STAGE(PG8_SB(1, 1), b3 + hstep, voffB);
            PG8_WAIT_V(6); PG8_BAR; PG8_MMA(1, 1, At, B1); PG8_BAR;
            }
        }
        if constexpr (ALIGN_EPI) { if (wr == 0) PG8_BAR; }
        { int te = threadIdx.x; asm volatile("" : "+v"(te));
          E(acc, cur, wr, wc, te & 15, (te & 63) >> 4); } S.done(cur);
        if (!has_next) break;
#pragma unroll
        for (int a = 0; a < 2; ++a)
#pragma unroll
            for (int b = 0; b < 2; ++b)
#pragma unroll
                for (int m = 0; m < 4; ++m)
#pragma unroll
                    for (int n = 0; n < 2; ++n) acc[a][b][m][n] = (f32x4){0.f, 0.f, 0.f, 0.f};
        cur = nxt; cA = nA; cB = nB; ++ui;
        if constexpr (ALIGN_EPI) { if (wr == 1) PG8_BAR; }
    }
    PG8_WAIT_V(0);
    if constexpr (!ALIGN_EPI) { if (wr == 0) PG8_BAR; }
    PG8_BAR;
#undef voffB
#undef PG8_SA
#undef PG8_SB
#undef PG8_STAGE
#undef PG8_LDA
#undef PG8_LDB
#undef PG8_MMA
#undef PG8_WAIT_V
#undef PG8_WAIT_L
#undef PG8_BAR
#undef PG8_SCHED
}
}

namespace att {
constexpr float SCALE = 0.08838834764831845f;
constexpr float THR = 8.f;
constexpr int NW = 8, QBLK = 32, KVBLK = 64, QB = NW * QBLK;
constexpr int SHM_V = KVBLK * HD * 2, SHM_K = KVBLK * HD * 2;
#define KSWZ(row, colB) ((row) * 256 + ((colB) ^ (((row) & 7) << 4)))
#define SBAR() __builtin_amdgcn_sched_barrier(0)
__device__ __forceinline__ int v_st(int k, int c) { const int kk = (k & ~0xC) | ((k & 4) << 1) | ((k & 8) >> 1); return ((kk >> 3) * 4 + (c >> 5)) * 512 + ((kk & 7) * 32 + (c & 31)) * 2; }
__device__ __forceinline__ int v_rd_base(int lane) { return ((lane & 3) << 3) | (((lane >> 2) & 3) << 6) | (((lane >> 4) & 1) << 5) | (((lane >> 5) & 1) << 8); }
constexpr int v_rd_off(int d0, int ks, int half) { return d0 * 512 + ks * 4096 + half * 2048; }
__device__ __forceinline__ int crow(int r, int hi) { return (r & 3) + 8 * (r >> 2) + 4 * hi; }
__device__ __forceinline__ unsigned cvtpk(float lo, float hi) { unsigned r; asm volatile("v_cvt_pk_bf16_f32 %0, %1, %2" : "=v"(r) : "v"(lo), "v"(hi)); return r; }
__device__ __forceinline__ bf16x8 ld8(const bf16* p) { return *reinterpret_cast<const bf16x8*>(p); }
__device__ __forceinline__ void mask_tile(f32x16& p0, f32x16& p1, int dq, unsigned W) {
    const float NEG = -__builtin_inff();
#pragma unroll
    for (int r = 0; r < 16; ++r) {
        const int c = (r & 3) + 8 * (r >> 2);
        if ((unsigned)(dq - c) >= W) p0[r] = NEG;
        if ((unsigned)(dq - c - 32) >= W) p1[r] = NEG;
    }
}
__device__ __forceinline__ void partialSM(f32x16& p0, f32x16& p1, float& m_reg, float& mn, float& alpha) {
    float pmax = p0[0]; for (int r = 1; r < 16; ++r) pmax = fmaxf(pmax, p0[r]); for (int r = 0; r < 16; ++r) pmax = fmaxf(pmax, p1[r]);
    { auto rr = __builtin_amdgcn_permlane32_swap(__float_as_uint(pmax), __float_as_uint(pmax), false, false);
      pmax = fmaxf(__uint_as_float(rr[0]), __uint_as_float(rr[1])); }
    constexpr float C2 = 1.4426950408889634f * SCALE;
    if (__builtin_expect(__all((pmax - m_reg) * SCALE <= THR), 1)) { mn = m_reg; alpha = 1.f; }
    else { mn = fmaxf(m_reg, pmax); alpha = __builtin_amdgcn_exp2f((m_reg - mn) * C2); m_reg = mn; }
    const float mnL = -mn * C2;
    for (int r = 0; r < 16; ++r) p0[r] = fmaf(p0[r], C2, mnL); for (int r = 0; r < 16; ++r) p1[r] = fmaf(p1[r], C2, mnL);
    for (int r = 0; r < 16; ++r) p0[r] = __builtin_amdgcn_exp2f(p0[r]);
}
__device__ __forceinline__ void finishSM(f32x16& p0, f32x16& p1, float alpha, float& l_reg, bf16x8& pa0, bf16x8& pa1, bf16x8& pa2, bf16x8& pa3) {
    for (int r = 0; r < 16; ++r) p1[r] = __builtin_amdgcn_exp2f(p1[r]);
    float ps = 0; for (int r = 0; r < 16; ++r) ps += p0[r]; for (int r = 0; r < 16; ++r) ps += p1[r];
    { auto rr = __builtin_amdgcn_permlane32_swap(__float_as_uint(ps), __float_as_uint(ps), false, false);
      ps = __uint_as_float(rr[0]) + __uint_as_float(rr[1]); }
    l_reg = l_reg * alpha + ps;
#define PK4(P, B_, OUT) do { unsigned a0 = cvtpk(P[B_+0], P[B_+1]), a1 = cvtpk(P[B_+2], P[B_+3]);                          \
        unsigned b0 = cvtpk(P[B_+4], P[B_+5]), b1 = cvtpk(P[B_+6], P[B_+7]);                                             \
        auto r0 = __builtin_amdgcn_permlane32_swap(a0, b0, false, false); auto r1 = __builtin_amdgcn_permlane32_swap(a1, b1, false, false); \
        u32x4 w = {r0[0], r1[0], r0[1], r1[1]}; OUT = *reinterpret_cast<bf16x8*>(&w); } while (0)
    PK4(p0, 0, pa0); PK4(p0, 8, pa1); PK4(p1, 0, pa2); PK4(p1, 8, pa3);
#undef PK4
}
template <int KB, bool SK>
__device__ __forceinline__ void qkt(f32x16& p0, f32x16& p1, const char* K_lds, int r32, int hi, const bf16x8* qr, bool act) {
    if (SK && !act) { const float NEG = -__builtin_inff();
#pragma unroll
        for (int r = 0; r < 16; ++r) { p0[r] = NEG; p1[r] = NEG; } return; }
    p0 = f32x16{}; p1 = f32x16{};
    const char* kb[4];
#pragma unroll
    for (int dd = 0; dd < 4; ++dd) kb[dd] = K_lds + KB * SHM_K + KSWZ(r32, (dd * 16 + hi * 8) * 2);
#pragma unroll
    for (int d0 = 0; d0 < 8; ++d0) { const char* a = kb[d0 & 3] + (d0 >> 2) * 128;
        bf16x8 b0 = *reinterpret_cast<const bf16x8*>(a);
        bf16x8 b1 = *reinterpret_cast<const bf16x8*>(a + 32 * 256);
        p0 = __builtin_amdgcn_mfma_f32_32x32x16_bf16(b0, qr[d0], p0, 0, 0, 0);
        p1 = __builtin_amdgcn_mfma_f32_32x32x16_bf16(b1, qr[d0], p1, 0, 0, 0); }
}
#define TRRD(dst, off) asm volatile("ds_read_b64_tr_b16 %0, %1 offset:%2" : "=&v"(dst) : "v"(vb0), "i"(off) : "memory")
#define PV_D0(VBv, d0, oo) do { s16x4 l0, l1, l2, l3, h0, h1, h2, h3; constexpr int b_ = (VBv) * att::SHM_V + att::v_rd_off(d0, 0, 0); \
        TRRD(l0, b_); TRRD(h0, b_ + 2048); TRRD(l1, b_ + 4096); TRRD(h1, b_ + 6144); TRRD(l2, b_ + 8192); TRRD(h2, b_ + 10240); TRRD(l3, b_ + 12288); TRRD(h3, b_ + 14336); \
        asm volatile("s_waitcnt lgkmcnt(0)" ::: "memory"); SBAR(); \
        oo = __builtin_amdgcn_mfma_f32_32x32x16_bf16(pa0, (bf16x8){l0[0], l0[1], l0[2], l0[3], h0[0], h0[1], h0[2], h0[3]}, oo, 0, 0, 0);   \
        oo = __builtin_amdgcn_mfma_f32_32x32x16_bf16(pa1, (bf16x8){l1[0], l1[1], l1[2], l1[3], h1[0], h1[1], h1[2], h1[3]}, oo, 0, 0, 0);   \
        oo = __builtin_amdgcn_mfma_f32_32x32x16_bf16(pa2, (bf16x8){l2[0], l2[1], l2[2], l2[3], h2[0], h2[1], h2[2], h2[3]}, oo, 0, 0, 0);   \
        oo = __builtin_amdgcn_mfma_f32_32x32x16_bf16(pa3, (bf16x8){l3[0], l3[1], l3[2], l3[3], h3[0], h3[1], h3[2], h3[3]}, oo, 0, 0, 0); } while (0)

struct BlockRef { int tok0, h, br, P0, dil; };
struct Bases { const bf16* Z; bf16* OB; float* LSE; };
#define BR_PIN(r) ((r).dil * ZP)
#define BR_ZB(r) (B.Z + (size_t)(r).tok0 * ZP + (r).h * HD)
#define BR_Q(r) (BR_ZB(r) + (size_t)(r).P0 * BR_PIN(r))
#define BR_K(r) (BR_ZB(r) + AW)
#define BR_V(r) (BR_ZB(r) + 2 * AW)
#define PVT_D0(VBv, d0, oo) do { s16x4 l0, l1, l2, l3, h0, h1, h2, h3; constexpr int b_ = (VBv) * att::SHM_V + att::v_rd_off(d0, 0, 0); \
        TRRD(l0, b_); TRRD(h0, b_ + 2048); TRRD(l1, b_ + 4096); TRRD(h1, b_ + 6144); TRRD(l2, b_ + 8192); TRRD(h2, b_ + 10240); TRRD(l3, b_ + 12288); TRRD(h3, b_ + 14336); \
        asm volatile("s_waitcnt lgkmcnt(0)" ::: "memory"); SBAR(); \
        oo = __builtin_amdgcn_mfma_f32_32x32x16_bf16((bf16x8){l0[0], l0[1], l0[2], l0[3], h0[0], h0[1], h0[2], h0[3]}, pa0, oo, 0, 0, 0);   \
        oo = __builtin_amdgcn_mfma_f32_32x32x16_bf16((bf16x8){l1[0], l1[1], l1[2], l1[3], h1[0], h1[1], h1[2], h1[3]}, pa1, oo, 0, 0, 0);   \
        oo = __builtin_amdgcn_mfma_f32_32x32x16_bf16((bf16x8){l2[0], l2[1], l2[2], l2[3], h2[0], h2[1], h2[2], h2[3]}, pa2, oo, 0, 0, 0);   \
        oo = __builtin_amdgcn_mfma_f32_32x32x16_bf16((bf16x8){l3[0], l3[1], l3[2], l3[3], h3[0], h3[1], h3[2], h3[3]}, pa3, oo, 0, 0, 0); } while (0)
template <int VB>
__device__ __forceinline__ void pvt_tile(f32x16* o, int vb0, bf16x8 pa0, bf16x8 pa1, bf16x8 pa2, bf16x8 pa3, bool act) {
    if (!act) return;
    PVT_D0(VB, 0, o[0]); PVT_D0(VB, 1, o[1]); PVT_D0(VB, 2, o[2]); PVT_D0(VB, 3, o[3]);
}
constexpr int QST_OFF = 2 * SHM_V + 3 * SHM_K;
__device__ __forceinline__ void swa_item(const BlockRef& cur, const BlockRef& nxt, const Bases& B, char* lds, LAS unsigned char* ldsl, const int tid, const bool first) {
    constexpr int W = 129;
    const int wid = __builtin_amdgcn_readfirstlane(tid >> 6), lane = tid & 63, r32 = lane & 31, hi = lane >> 5;
    const int kb0 = cur.P0 - 128;
    const int qlo = cur.P0 + wid * QBLK, qm = qlo + r32 - 4 * hi;
    char* K_lds = lds + 2 * SHM_V;
    const int vb0 = (int)(uintptr_t)lds + v_rd_base(lane);
    int kpk[2], vpk[2];
#pragma unroll
    for (int i = 0; i < 2; ++i) { const int c = 2 * wid + i;
        const int row = 4 * c + (lane >> 4), c16 = lane & 15; kpk[i] = row * 256 + ((c16 ^ (row & 7)) * 8);
        const int q = c * 64 + lane, sub = q >> 5, r = q & 31, kk = (sub >> 2) * 8 + (r >> 2), c8 = (sub & 3) * 4 + (r & 3), k = (kk & ~0xC) | ((kk & 4) << 1) | ((kk & 8) >> 1);
        vpk[i] = k * 256 + c8 * 8; }
    const unsigned kdst = (unsigned)(2 * SHM_V) + (unsigned)wid * 2048u, vdst = (unsigned)wid * 2048u, qdst = (unsigned)QST_OFF + (unsigned)wid * 8192u;
#define DMA_KX(ref, t) do { const int pin_ = BR_PIN(ref); const int kbc_ = (ref).P0 - 128 + 64 * (t); const bf16* g_ = BR_K(ref) + (long)(kbc_ < 0 ? 0 : kbc_) * pin_; _Pragma("unroll") for (int _i = 0; _i < 2; ++_i) \
        __builtin_amdgcn_global_load_lds((const unsigned*)(g_ + (unsigned)((kpk[_i] >> 8) * pin_ + (kpk[_i] & 255))), (LAS unsigned*)(ldsl + kdst + ((t) % 3) * SHM_K + _i * 1024), 16, 0, 0); } while (0)
#define DMA_VX(ref, t) do { const int pin_ = BR_PIN(ref); const int kbc_ = (ref).P0 - 128 + 64 * (t); const bf16* g_ = BR_V(ref) + (long)(kbc_ < 0 ? 0 : kbc_) * pin_; _Pragma("unroll") for (int _i = 0; _i < 2; ++_i) \
        __builtin_amdgcn_global_load_lds((const unsigned*)(g_ + (unsigned)((vpk[_i] >> 8) * pin_ + (vpk[_i] & 255))), (LAS unsigned*)(ldsl + vdst + ((t) % 2) * SHM_V + _i * 1024), 16, 0, 0); } while (0)
#define DMA_Q(ref) do { const int pin_ = BR_PIN(ref); const bf16* g_ = BR_Q(ref) + (size_t)(wid * QBLK) * pin_; _Pragma("unroll") for (int j_ = 0; j_ < 8; ++j_) { const int row_ = 4 * j_ + (lane >> 4); \
        __builtin_amdgcn_global_load_lds((const unsigned*)(g_ + (unsigned)(row_ * pin_ + (((lane & 15) ^ (row_ & 15)) * 8))), (LAS unsigned*)(ldsl + qdst + j_ * 1024), 16, 0, 0); } } while (0)
#define WAITV(n) asm volatile("s_waitcnt vmcnt(" #n ")" ::: "memory")
#define BARV(n) do { WAITV(n); __builtin_amdgcn_s_barrier(); asm volatile("" ::: "memory"); } while (0)
    if (first) { DMA_Q(cur); DMA_KX(cur, 0); DMA_VX(cur, 0); DMA_KX(cur, 1); WAITV(6); } else { WAITV(9); }
    bf16x8 qr[8];
#pragma unroll
    for (int d0 = 0; d0 < 8; ++d0) qr[d0] = *(const bf16x8*)(lds + qdst + r32 * 256 + (((2 * d0 + hi) ^ (r32 & 15)) << 4));
    asm volatile("s_waitcnt lgkmcnt(0)" ::: "memory");
    float m_reg = -1e30f, l_reg = 0; f32x16 o[4] = {};
#define RESC(a) do { if (__any((a) < 1.f)) { for (int d_ = 0; d_ < 4; ++d_) for (int r = 0; r < 16; ++r) o[d_][r] *= (a); } } while (0)
#define KBASE(t) (kb0 + 64 * (t))
#define ACT(t) (KBASE(t) >= 0 && KBASE(t) <= qlo + QBLK - 1 && KBASE(t) + KVBLK - 1 >= qlo - W + 1)
#define MASKT(P0_, P1_, t) do { const int kb_ = KBASE(t); if (kb_ + KVBLK - 1 > qlo || kb_ <= qlo + QBLK - 1 - W) mask_tile(P0_, P1_, qm - kb_, (unsigned)W); } while (0)
#define STEP(t, WAITS, ISSUE) do {                                                                                           \
        WAITS; ISSUE;                                                                                                        \
        if (ACT(t)) { f32x16 p0, p1; float mn, al; bf16x8 pa0, pa1, pa2, pa3;                                                \
            SBAR(); qkt<(t) % 3, false>(p0, p1, K_lds, r32, hi, qr, true);                                                  \
            MASKT(p0, p1, (t)); partialSM(p0, p1, m_reg, mn, al); RESC(al);                                                  \
            finishSM(p0, p1, al, l_reg, pa0, pa1, pa2, pa3); SBAR();                                                         \
            pvt_tile<(t) % 2>(o, vb0, pa0, pa1, pa2, pa3, true); } } while (0)
    STEP(0, do { if (first) BARV(2); else BARV(9); } while (0), do { DMA_VX(cur, 1); DMA_KX(cur, 2); } while (0));
    STEP(1, BARV(2), do { DMA_VX(cur, 2); DMA_KX(cur, 3); } while (0));
    STEP(2, BARV(2), do { DMA_VX(cur, 3); DMA_KX(cur, 4); } while (0));
    STEP(3, BARV(2), do { DMA_VX(cur, 4); DMA_KX(cur, 5); } while (0));
    STEP(4, BARV(2), do { DMA_VX(cur, 5); DMA_KX(nxt, 0); } while (0));
    STEP(5, BARV(2), do { DMA_VX(nxt, 0); DMA_KX(nxt, 1); DMA_Q(nxt); } while (0));
    const float inv = __builtin_amdgcn_rcpf(l_reg);
    const int pout = cur.dil * AW;
    char* Orow = (char*)(B.OB + ((size_t)cur.br * MTOK + cur.tok0) * AW + cur.h * HD + (size_t)(cur.P0 + wid * QBLK + r32) * pout) + hi * 16;
#pragma unroll
    for (int d0 = 0; d0 < 4; ++d0)
#pragma unroll
        for (int pr = 0; pr < 2; ++pr) {
            unsigned ax = cvtpk(o[d0][8 * pr + 0] * inv, o[d0][8 * pr + 1] * inv), ay = cvtpk(o[d0][8 * pr + 2] * inv, o[d0][8 * pr + 3] * inv);
            unsigned bx = cvtpk(o[d0][8 * pr + 4] * inv, o[d0][8 * pr + 5] * inv), by = cvtpk(o[d0][8 * pr + 6] * inv, o[d0][8 * pr + 7] * inv);
            auto rx = __builtin_amdgcn_permlane32_swap(ax, bx, false, false); auto ry = __builtin_amdgcn_permlane32_swap(ay, by, false, false);
            u32x4 w = {rx[0], ry[0], rx[1], ry[1]};
            *(u32x4*)(Orow + 16 * (4 * d0 + 2 * pr)) = w; }
    if (hi == 0) B.LSE[((size_t)cur.br * MTOK + cur.tok0) * NAH + cur.h + (size_t)(cur.P0 + wid * QBLK + r32) * (cur.dil * NAH)] = m_reg * SCALE + __builtin_amdgcn_logf(l_reg) * 0.6931471805599453f;
#undef RESC
#undef KBASE
#undef ACT
#undef MASKT
#undef STEP
#undef DMA_KX
#undef DMA_VX
#undef DMA_Q
#undef WAITV
#undef BARV
}
}

constexpr int NWAVES = 8;
constexpr size_t MiB = 1u << 20;
constexpr size_t WS_CTL = 0, CTL_ZERO_BYTES = 3 * MiB + 512 * 1024;
constexpr size_t WS_SSQ = 1 * MiB;
constexpr size_t WS_BIASR = 2 * MiB + 256 * 1024;
constexpr size_t WS_MODV = 8 * MiB;
constexpr size_t WS_ROPE = 9 * MiB;
constexpr size_t WS_SGUW = 13 * MiB;
constexpr size_t WS_LSE = 14 * MiB;
constexpr size_t WS_PART = 20 * MiB;
constexpr size_t WS_W = 44 * MiB;
constexpr size_t SZ_WINE = (size_t)MIXIN * DM * 2, SZ_WSQ = (size_t)DM * DM * 2, SZ_WINO = (size_t)CIN * DM * 2, SZ_WGU = (size_t)NGU * DM * 2, SZ_WD = (size_t)DM * DFF * 2;
constexpr size_t WS_WINE = WS_W, WS_WOUTE = WS_WINE + 2 * SZ_WINE, WS_WINO = WS_WOUTE + 2 * SZ_WSQ, WS_WOUTO = WS_WINO + 2 * SZ_WINO, WS_WGU = WS_WOUTO + 2 * SZ_WSQ, WS_WD = WS_WGU + 4 * SZ_WGU;
constexpr size_t WS_H = 432 * MiB;
constexpr size_t WS_Z = 560 * MiB;
constexpr size_t WS_AO = 944 * MiB;
constexpr size_t WS_OB = 1072 * MiB;
constexpr size_t WS_XB = 1360 * MiB;
constexpr size_t WS_END = 1488 * MiB;
constexpr size_t BIAS_INE = 0, BIAS_INO = BIAS_INE + 2 * 4 * MIXIN, BIAS_GU = BIAS_INO + 2 * 4 * CIN, BIAS_END = BIAS_GU + 4 * 4 * NGU;
static_assert(WS_SSQ + 9 * (size_t)MTOK * sizeof(u64) <= WS_BIASR && WS_BIASR + BIAS_END * sizeof(i64) <= CTL_ZERO_BYTES, "zeroed region");
static_assert(WS_WD + 4 * SZ_WD <= WS_H, "weights fit");
constexpr int CW_TMO = 0, CW_BAR = 4096;
constexpr int RING_OFF = 0, RING_BYTES = 131072;
constexpr int LDSCTL_OFF = 147456, MISC_OFF = LDSCTL_OFF + 320;
constexpr int LDS_BYTES = 155648;

typedef GAS unsigned gu32;
#define RLX_AGENT __ATOMIC_RELAXED, __HIP_MEMORY_SCOPE_AGENT
#define LDS_WAIT() asm volatile("s_waitcnt lgkmcnt(0)" ::: "memory")
#define VM_WAIT() asm volatile("s_waitcnt vmcnt(0)" ::: "memory")

#define XB_TMO      128
#define XB_XCNT(j)  (256  + 64 * (j))
#define XB_XSUB(j)  (1280 + 64 * (j))
#define XB_XGEN(j)  (2304 + 64 * (j))
#define XB_TOP      3328
#define XB_TOPGEN   3392
#define XCD_BAR_WORDS 3456
#define XB_SPIN_CAP (1u << 18)
__device__ __forceinline__ unsigned xb_ld(unsigned* p)              { return __hip_atomic_load(p, __ATOMIC_RELAXED, __HIP_MEMORY_SCOPE_AGENT); }
__device__ __forceinline__ unsigned xb_add(unsigned* p, unsigned v) { return __hip_atomic_fetch_add(p, v, __ATOMIC_RELAXED, __HIP_MEMORY_SCOPE_AGENT); }
__device__ __forceinline__ unsigned xb_xcc_id() { return (unsigned)__builtin_amdgcn_s_getreg((3 << 11) | 20) & 0xFu; }
#define XB_SPIN(cond, bar) do { unsigned _sp = 0; while (cond) { __builtin_amdgcn_s_sleep(1); \
    if ((++_sp & 255u) == 0u) { if (xb_ld(&(bar)[XB_TMO])) break; if (_sp > XB_SPIN_CAP) { atomicAdd(&(bar)[XB_TMO], 1u); break; } } } } while (0)
struct XcdBarrier { unsigned* bar; unsigned x; volatile LAS unsigned* st; };
__device__ __forceinline__ XcdBarrier xcd_barrier_post(unsigned* bar, volatile LAS unsigned* st) {
    XcdBarrier b; b.bar = bar; b.x = xb_xcc_id(); b.st = st;
    if (threadIdx.x == 0) (void)xb_add(&bar[XB_XCNT(b.x)], 1u);
    return b;
}
__device__ __forceinline__ void xcd_barrier_complete(unsigned* bar, unsigned x, unsigned& nloc, unsigned& nx) {
    const unsigned G = gridDim.x * gridDim.y * gridDim.z;
    unsigned sum, cnt, mine, sp = 0u;
    for (;;) {
        sum = 0u; cnt = 0u; mine = 0u;
#pragma unroll
        for (unsigned j = 0; j < 16; ++j) { const unsigned c = xb_ld(&bar[XB_XCNT(j)]); sum += c; cnt += (c > 0u) ? 1u : 0u; mine = (j == x) ? c : mine; }
        if (sum == G) break;
        __builtin_amdgcn_s_sleep(1);
        if ((++sp & 255u) == 0u) { if (xb_ld(&bar[XB_TMO])) break; if (sp > XB_SPIN_CAP) { atomicAdd(&bar[XB_TMO], 1u); break; } }
    }
    nloc = mine > 0u ? mine : 1u; nx = cnt > 0u ? cnt : 1u;
}
__device__ __forceinline__ void xcd_barrier(const XcdBarrier& b) {
    asm volatile("s_waitcnt vmcnt(0)" ::: "memory");
    __syncthreads();
    if (threadIdx.x == 0) {
        unsigned* bar = b.bar;
        __builtin_amdgcn_s_waitcnt(0);
        unsigned nloc = b.st[0], nx = b.st[1];
        if (nloc == 0u) { xcd_barrier_complete(bar, b.x, nloc, nx); b.st[0] = nloc; b.st[1] = nx; }
        const unsigned old = xb_add(&bar[XB_XSUB(b.x)], 1u);
        const unsigned gen = old / nloc;
        if (old + 1u == (gen + 1u) * nloc) {
            __builtin_amdgcn_fence(__ATOMIC_RELEASE, "agent");
            asm volatile("s_waitcnt vmcnt(0)" ::: "memory");
            const unsigned og = xb_add(&bar[XB_TOP], 1u);
            const unsigned tg = og / nx;
            if (og + 1u == (tg + 1u) * nx) xb_add(&bar[XB_TOPGEN], 1u);
            else XB_SPIN(xb_ld(&bar[XB_TOPGEN]) == tg, bar);
            __builtin_amdgcn_fence(__ATOMIC_ACQUIRE, "agent");
            asm volatile("s_waitcnt vmcnt(0)" ::: "memory");
        } else {
            XB_SPIN(xb_ld(&bar[XB_TOPGEN]) == gen, bar);
            __builtin_amdgcn_fence(__ATOMIC_ACQUIRE, "agent");
            asm volatile("s_waitcnt vmcnt(0)" ::: "memory");
        }
    }
    __syncthreads();
}

struct Args { const void* in[18]; float* out; unsigned char* ws; int ph_lo, ph_hi, dry, pad; };
enum { I_X = 0, I_C, I_POS, I_ADAW, I_ADAB, I_NMIX, I_NFFN, I_ABWIN, I_SGUW, I_SGUB, I_ABWOUT, I_CWIN, I_CW, I_CWOUT, I_FG, I_FU, I_FD, I_FNORM };

__device__ __forceinline__ float wave_sum(float v) {
    v += swz_xor<1>(v); v += swz_xor<2>(v); v += swz_xor<4>(v); v += swz_xor<8>(v); v += swz_xor<16>(v);
    auto rr = __builtin_amdgcn_permlane32_swap(__float_as_uint(v), __float_as_uint(v), false, false);
    return __uint_as_float(rr[0]) + __uint_as_float(rr[1]);
}
__device__ __forceinline__ unsigned pk2(float lo, float hi) { return cvt_pk_bf16(lo, hi); }

__device__ __forceinline__ void p0_transpose_item(const float* W, int ldn, int col0, int k0, bf16* WT, int K, int drow0, bool perm, LAS float* scr, int lane, const float* shv, i64* biasr, int bN) {
    float wv[32];
#pragma unroll
    for (int i = 0; i < 32; ++i) { const int kk = 2 * i + (lane >> 5); wv[i] = W[(size_t)(k0 + kk) * ldn + col0 + (lane & 31)]; }
#pragma unroll
    for (int i = 0; i < 32; ++i) { const int kk = 2 * i + (lane >> 5); scr[kk * 33 + (lane & 31)] = wv[i]; }
    if (biasr) {
        LAS float* scs = scr + 64 * 33;
#pragma unroll
        for (int b = 0; b < 4; ++b) scs[b * 64 + lane] = shv[(size_t)b * 6 * DM + k0 + lane];
    }
    LDS_WAIT(); asm volatile("" ::: "memory");
    if (biasr) {
        const LAS float* scs = scr + 64 * 33;
        const int rho = lane & 31, kh = lane >> 5, src = perm ? pg8::perm32(rho) : rho;
        float a0 = 0.f, a1 = 0.f, a2 = 0.f, a3 = 0.f;
#pragma unroll 8
        for (int k2 = 0; k2 < 32; ++k2) { const int kk = 32 * kh + k2; const float w = scr[kk * 33 + src];
            a0 += w * scs[kk]; a1 += w * scs[64 + kk]; a2 += w * scs[128 + kk]; a3 += w * scs[192 + kk]; }
        a0 = half_sum(a0); a1 = half_sum(a1); a2 = half_sum(a2); a3 = half_sum(a3);
        if (lane < 32) { i64* bp = biasr + rho;
            __hip_atomic_fetch_add(bp, (i64)(a0 * BIAS_SCALE), __ATOMIC_RELAXED, __HIP_MEMORY_SCOPE_AGENT); __hip_atomic_fetch_add(bp + bN, (i64)(a1 * BIAS_SCALE), __ATOMIC_RELAXED, __HIP_MEMORY_SCOPE_AGENT);
            __hip_atomic_fetch_add(bp + 2 * bN, (i64)(a2 * BIAS_SCALE), __ATOMIC_RELAXED, __HIP_MEMORY_SCOPE_AGENT); __hip_atomic_fetch_add(bp + 3 * bN, (i64)(a3 * BIAS_SCALE), __ATOMIC_RELAXED, __HIP_MEMORY_SCOPE_AGENT); }
    }
    const int c = lane & 7;
#pragma unroll
    for (int j = 0; j < 4; ++j) { const int rho = (lane >> 3) + 8 * j; const int src = perm ? pg8::perm32(rho) : rho; const LAS float* s = scr + (8 * c) * 33 + src;
        u32x4 o; o.x = pk2(s[0 * 33], s[1 * 33]); o.y = pk2(s[2 * 33], s[3 * 33]); o.z = pk2(s[4 * 33], s[5 * 33]); o.w = pk2(s[6 * 33], s[7 * 33]);
        *(GAS u32x4*)(WT + (size_t)(drow0 + rho) * K + k0 + 8 * c) = o; }
    LDS_WAIT(); asm volatile("" ::: "memory");
}

__device__ __forceinline__ void prenorm_rows(int gw, int lane, const float* xin, bf16* XB, bf16* outp, const float* A, int bstride, u64* ssq) {
    const int r0 = gw * 16, b = r0 / SEQ;
    f32x4 av[8];
#pragma unroll
    for (int j = 0; j < 8; ++j) av[j] = *(const f32x4*)(A + (size_t)b * bstride + 4 * (lane + 64 * j));
    for (int r = 0; r < 16; ++r) { const size_t row = (size_t)(r0 + r);
        const f32x4* xr = (const f32x4*)(xin + row * DM) + lane;
        f32x4 v[8]; float ss = 0.f;
#pragma unroll
        for (int j = 0; j < 8; ++j) v[j] = xr[64 * j];
#pragma unroll
        for (int j = 0; j < 8; ++j) { u32x2 w; w.x = pk2(v[j].x, v[j].y); w.y = pk2(v[j].z, v[j].w); *((u32x2*)(XB + row * DM) + lane + 64 * j) = w;
            v[j] = (f32x4){bf_lo(w.x), bf_hi(w.x), bf_lo(w.y), bf_hi(w.y)}; ss += (v[j].x * v[j].x + v[j].y * v[j].y) + (v[j].z * v[j].z + v[j].w * v[j].w); }
        ss = wave_sum(ss);
        if (lane == 0) ssq[row] = (u64)(ss * SSQ_SCALE + 0.5f);
#pragma unroll
        for (int j = 0; j < 8; ++j) { const f32x4 o = v[j] * av[j]; u32x2 w; w.x = pk2(o.x, o.y); w.y = pk2(o.z, o.w); *((u32x2*)(outp + row * DM) + lane + 64 * j) = w; }
    }
}
__device__ __forceinline__ void final_rows(int gw, int lane, const bf16* XB, float* outp, const float* A, const u64* ssq) {
    f32x4 av[4][2];
#pragma unroll
    for (int j = 0; j < 4; ++j) { av[j][0] = *(const f32x4*)(A + 8 * (lane + 64 * j)); av[j][1] = *(const f32x4*)(A + 8 * (lane + 64 * j) + 4); }
    for (int rb = 0; rb < 16; rb += 4) {
        u32x4 xq[4][4]; u64 sq[4];
#pragma unroll
        for (int r = 0; r < 4; ++r) { const size_t row = (size_t)gw * 16 + rb + r; sq[r] = ssq[row];
#pragma unroll
            for (int j = 0; j < 4; ++j) xq[r][j] = *((const u32x4*)(XB + row * DM) + lane + 64 * j); }
#pragma unroll
        for (int r = 0; r < 4; ++r) { const size_t row = (size_t)gw * 16 + rb + r; const float rstd = 1.0f / sqrtf((float)sq[r] * (1.0f / (SSQ_SCALE * DM)) + EPS);
#pragma unroll
            for (int j = 0; j < 4; ++j) { const u32x4 xi = xq[r][j];
                float* op = outp + row * DM + 8 * (lane + 64 * j);
                *(f32x4*)op = (f32x4){bf_lo(xi.x), bf_hi(xi.x), bf_lo(xi.y), bf_hi(xi.y)} * rstd * av[j][0];
                *(f32x4*)(op + 4) = (f32x4){bf_lo(xi.z), bf_hi(xi.z), bf_lo(xi.w), bf_hi(xi.w)} * rstd * av[j][1]; } }
    }
}


typedef __attribute__((address_space(4))) const char kargc;
__device__ __forceinline__ const void* karg(int idx) {
    asm volatile("" : "+s"(idx));
    kargc* kp = (kargc*)__builtin_amdgcn_kernarg_segment_ptr();
    return *(const void* __attribute__((address_space(4))) const*)(kp + (size_t)idx * 8);
}
#define KIN(i) karg(i)
#define KOUT() ((float*)karg(18))
#define KWS() ((unsigned char*)karg(19))

__device__ __forceinline__ att::BlockRef att_mkref(int L, int G) {
    const int rnd = L / G, w = L - rnd * G; const int xx = (w + rnd) & 31; const int bh = (rnd / 3) * 8 + (w >> 5), br = rnd % 3;
    const int dsh = 2 * br, nqb = 32 >> dsh;
    const int rr = xx / nqb, qb = xx % nqb, b = bh / NAH, h = bh % NAH;
    att::BlockRef R; R.tok0 = b * SEQ + rr; R.h = h; R.br = br; R.P0 = qb * att::QB; R.dil = 1 << dsh;
    return R;
}

__global__ void __launch_bounds__(NWAVES * 64, 2) mega_fwd(Args args) {
    extern __shared__ __attribute__((aligned(16))) unsigned char lds[];
    LAS unsigned char* ldsl = (LAS unsigned char*)lds;
    volatile LAS unsigned* MISC = (volatile LAS unsigned*)(ldsl + MISC_OFF);
    const int tid0 = threadIdx.x, wave = __builtin_amdgcn_readfirstlane(tid0 >> 6);
#define OPAQUE_TID() int tid = threadIdx.x; asm volatile("" : "+v"(tid)); const int lane = tid & 63; (void)lane
    const int G = gridDim.x; const int bx = blockIdx.x; const int vcu = (G % 8 == 0) ? (bx % 8) * (G / 8) + bx / 8 : bx;
    const int gw = vcu * NWAVES + wave, NGW = G * NWAVES;
    gu32* ctl = (gu32*)(args.ws + WS_CTL);
    for (int u = tid0; u < (LDS_BYTES - LDSCTL_OFF) / 4; u += NWAVES * 64) ((LAS unsigned*)(ldsl + LDSCTL_OFF))[u] = 0u;
    __syncthreads();
    XcdBarrier bar; bar.bar = (unsigned*)(ctl + CW_BAR); bar.x = 0; bar.st = nullptr;
    if (!MK_PER_PHASE) bar = xcd_barrier_post((unsigned*)(ctl + CW_BAR), MISC + 8);
    const int lo = args.ph_lo, hi = args.ph_hi;
#define IN(k) (lo <= (k) && (k) < hi)
#define SEAM(k) do { if (!MK_PER_PHASE && (k) + 1 < hi) xcd_barrier(bar); } while (0)

    if (IN(0)) { OPAQUE_TID(); unsigned char* ws = KWS(); float* PART = (float*)(ws + WS_PART);
        { const float* cin = (const float*)KIN(I_C); const float* adaw = (const float*)KIN(I_ADAW);
          for (int it = gw; it < 4 * 32 * 48; it += NGW) { const int ng = it % 48, kc = (it / 48) % 32, l = it / (48 * 32);
              const int k0 = 64 * kc, n0 = 256 * ng;
              float ca[4];
#pragma unroll
              for (int b = 0; b < 4; ++b) ca[b] = silu_f(cin[b * DM + k0 + lane]);
              f32x4 ac[4];
#pragma unroll
              for (int b = 0; b < 4; ++b) ac[b] = (f32x4){0.f, 0.f, 0.f, 0.f};
              const float* wp = adaw + ((size_t)l * DM + k0) * (6 * DM) + n0 + 4 * lane;
#pragma unroll 16
              for (int kk = 0; kk < 64; ++kk) { const f32x4 w = *(const f32x4*)(wp + (size_t)kk * (6 * DM));
#pragma unroll
                  for (int b = 0; b < 4; ++b) { const float s = __uint_as_float(__builtin_amdgcn_readlane(__float_as_uint(ca[b]), kk)); ac[b] += w * s; } }
#pragma unroll
              for (int b = 0; b < 4; ++b) *(f32x4*)(PART + ((size_t)((kc * 4 + l) * 4 + b)) * (6 * DM) + n0 + 4 * lane) = ac[b];
          } }
        { const int* pos = (const int*)KIN(I_POS); float* ROPE = (float*)(ws + WS_ROPE);
          for (int e = vcu * 512 + tid; e < MTOK * 16; e += G * 512) { const int row = e >> 4, i = e & 15;
              const double invf = exp2(-(double)i * (18.931568569324174 / 16.0));
              const double rev = (double)pos[row] * invf * 0.15915494309189535;
              const float fr = (float)(rev - floor(rev));
              ROPE[(size_t)row * 32 + i] = __builtin_amdgcn_cosf(fr); ROPE[(size_t)row * 32 + 16 + i] = __builtin_amdgcn_sinf(fr); } }
        { const float* sw = (const float*)KIN(I_SGUW); bf16* SGUW = (bf16*)(ws + WS_SGUW);
          for (int e = vcu * 512 + tid; e < 2 * 4 * 128 * 128; e += G * 512) { const int s = e & 127, t = (e >> 7) & 127;
              SGUW[e] = (bf16)(cvt_pk_bf16(s <= t ? sw[e] : 0.f, 0.f) & 0xffffu); } }
    }
    SEAM(0);
    if (IN(1)) { OPAQUE_TID(); unsigned char* ws = KWS(); float* PART = (float*)(ws + WS_PART); float* MODV = (float*)(ws + WS_MODV);
        const float* adab = (const float*)KIN(I_ADAB); const float* nmix = (const float*)KIN(I_NMIX); const float* nffn = (const float*)KIN(I_NFFN);
        for (int e = vcu * 512 + tid; e < 6 * 4 * 4 * DM; e += G * 512) { const int col = e % DM, b = (e / DM) % 4, l = (e / (4 * DM)) % 4, ch = e / (16 * DM);
            float pv[32];
#pragma unroll
            for (int kc = 0; kc < 32; ++kc) pv[kc] = PART[((size_t)((kc * 4 + l) * 4 + b)) * (6 * DM) + ch * DM + col];
            float sm = adab[l * 6 * DM + ch * DM + col];
#pragma unroll
            for (int kc = 0; kc < 32; ++kc) sm += pv[kc];
            const int slot = (ch == 0) ? 1 : (ch == 1) ? 0 : (ch == 3) ? 4 : (ch == 4) ? 3 : ch;
            float val = sm;
            if (ch == 1) val = nmix[l * DM + col] * (1.0f + sm);
            if (ch == 4) val = nffn[l * DM + col] * (1.0f + sm);
            MODV[((size_t)(l * 4 + b) * 6 + slot) * DM + col] = val; }
    }
    SEAM(1);
    if (IN(2)) { OPAQUE_TID(); unsigned char* ws = KWS(); const float* MODVc = (const float*)(ws + WS_MODV); i64* BIASR = (i64*)(ws + WS_BIASR);
        { LAS float* scr = (LAS float*)(ldsl + RING_OFF + wave * 16384);
          constexpr int C0 = 2 * 176 * 32, C1 = 2 * 64 * 32, C2 = 2 * 192 * 32, C3 = 2 * 64 * 32, C4 = 4 * 352 * 32, C5 = 4 * 64 * 88;
          constexpr int NIT = C0 + C1 + C2 + C3 + C4 + C5;
          for (int it = gw; it < NIT; it += NGW) { int r = it;
              if (r < C0) { const int i = r / (176 * 32), rem = r % (176 * 32), kb = rem / 176, gd = rem % 176;
                  p0_transpose_item((const float*)KIN(I_ABWIN) + (size_t)i * DM * MIXIN, MIXIN, 32 * gd, 64 * kb, (bf16*)(ws + WS_WINE + i * SZ_WINE), DM, 32 * gd, gd >= 96, scr, lane, MODVc + ((size_t)(2 * i) * 4 * 6 + 1) * DM, BIASR + BIAS_INE + (size_t)i * 4 * MIXIN + 32 * gd, MIXIN); continue; } r -= C0;
              if (r < C1) { const int i = r / (64 * 32), rem = r % (64 * 32), kb = rem / 64, gd = rem % 64;
                  p0_transpose_item((const float*)KIN(I_ABWOUT) + (size_t)i * DM * DM, DM, 32 * gd, 64 * kb, (bf16*)(ws + WS_WOUTE + i * SZ_WSQ), DM, 32 * gd, true, scr, lane, nullptr, nullptr, 0); continue; } r -= C1;
              if (r < C2) { const int i = r / (192 * 32), rem = r % (192 * 32), kb = rem / 192, gd = rem % 192; const int t = gd >> 3, w = gd & 7;
                  const int col0 = (t < 8) ? 32 * gd : ((w < 4) ? 2048 + 128 * (t - 8) + 32 * w : 4096 + 128 * (t - 8) + 32 * (w - 4));
                  p0_transpose_item((const float*)KIN(I_CWIN) + (size_t)i * DM * CIN, CIN, col0, 64 * kb, (bf16*)(ws + WS_WINO + i * SZ_WINO), DM, 32 * gd, true, scr, lane, MODVc + ((size_t)(2 * i + 1) * 4 * 6 + 1) * DM, BIASR + BIAS_INO + (size_t)i * 4 * CIN + 32 * gd, CIN); continue; } r -= C2;
              if (r < C3) { const int i = r / (64 * 32), rem = r % (64 * 32), kb = rem / 64, gd = rem % 64;
                  p0_transpose_item((const float*)KIN(I_CWOUT) + (size_t)i * DM * DM, DM, 32 * gd, 64 * kb, (bf16*)(ws + WS_WOUTO + i * SZ_WSQ), DM, 32 * gd, true, scr, lane, nullptr, nullptr, 0); continue; } r -= C3;
              if (r < C4) { const int l = r / (352 * 32), rem = r % (352 * 32), kb = rem / 352, gd = rem % 352; const int t = gd >> 3, w = gd & 7;
                  const float* src = (const float*)KIN((w < 4) ? I_FG : I_FU);
                  p0_transpose_item(src + (size_t)l * DM * DFF, DFF, 128 * t + 32 * (w & 3), 64 * kb, (bf16*)(ws + WS_WGU + l * SZ_WGU), DM, 32 * gd, true, scr, lane, MODVc + ((size_t)l * 4 * 6 + 4) * DM, BIASR + BIAS_GU + (size_t)l * 4 * NGU + 32 * gd, NGU); continue; } r -= C4;
              { const int l = r / (64 * 88), rem = r % (64 * 88), kb = rem / 64, gd = rem % 64;
                  p0_transpose_item((const float*)KIN(I_FD) + (size_t)l * DFF * DM, DM, 32 * gd, 64 * kb, (bf16*)(ws + WS_WD + l * SZ_WD), DFF, 32 * gd, true, scr, lane, nullptr, nullptr, 0); }
          } }
        prenorm_rows(gw, lane, (const float*)KIN(I_X), (bf16*)(ws + WS_XB), (bf16*)(ws + WS_H), MODVc, 6 * DM, (u64*)(ws + WS_SSQ) + (size_t)8 * MTOK);
    }
    SEAM(2);

    for (int layer = 0; layer < 4; ++layer) {
        const int pb = 3 + 8 * layer, li = layer >> 1; const bool even_layer = (layer & 1) == 0;
#define PH_SETUP() OPAQUE_TID(); unsigned char* ws = KWS(); const float* mv = (const float*)(ws + WS_MODV) + (size_t)layer * 4 * 6 * DM; (void)mv
        if (IN(pb + 1)) { PH_SETUP(); bf16* Hb = (bf16*)(ws + WS_H); bf16* Zb = (bf16*)(ws + WS_Z);
            if (even_layer) {
                pg8::Gemm g{Hb, (const bf16*)(ws + WS_WINE + li * SZ_WINE), MTOK, MIXIN, DM}; pg8::StaticOrder S; S.init(MTOK, MIXIN, G, bx);
                pg8::EpiInE E{Zb, (const float*)(ws + WS_ROPE), NormIn{(const u64*)(ws + WS_SSQ) + (size_t)(layer == 0 ? 8 : 2 * layer - 1) * MTOK, (const i64*)(ws + WS_BIASR) + BIAS_INE + (size_t)li * 4 * MIXIN, MIXIN, ldsl + LDSCTL_OFF + 1024}};
                pg8::gemm_phase<pg8::EpiInE, pg8::StaticOrder, true, true>(ldsl + RING_OFF, g, S, E, tid);
            } else {
                pg8::Gemm g{Hb, (const bf16*)(ws + WS_WINO + li * SZ_WINO), MTOK, CIN, DM}; pg8::StaticOrder S; S.init(MTOK, CIN, G, bx);
                pg8::EpiInO E{Zb, Zb + (size_t)MTOK * DM, NormIn{(const u64*)(ws + WS_SSQ) + (size_t)(2 * layer - 1) * MTOK, (const i64*)(ws + WS_BIASR) + BIAS_INO + (size_t)li * 4 * CIN, CIN, ldsl + LDSCTL_OFF + 1024}};
                pg8::gemm_phase<pg8::EpiInO, pg8::StaticOrder, true, true>(ldsl + RING_OFF, g, S, E, tid);
            }
        }
        SEAM(pb + 1);
        if (IN(pb + 2)) { PH_SETUP(); bf16* Zb = (bf16*)(ws + WS_Z); bf16* AO = (bf16*)(ws + WS_AO);
            if (even_layer) {
                {   constexpr int NITEM = 3 * 48 * 32; bf16* OB = (bf16*)(ws + WS_OB); float* LSE = (float*)(ws + WS_LSE);
                    const att::Bases BS{Zb, OB, LSE};
                    if (vcu < NITEM) { att::BlockRef cur = att_mkref(vcu, G); bool first = true;
                        for (int L = vcu; L < NITEM; L += G) { const att::BlockRef nxt = (L + G < NITEM) ? att_mkref(L + G, G) : cur;
                            att::swa_item(cur, nxt, BS, (char*)lds + RING_OFF, ldsl + RING_OFF, tid, first); cur = nxt; first = false; } }
                }
                VM_WAIT(); __syncthreads();
                {   const bf16* sgw = (const bf16*)(ws + WS_SGUW) + (size_t)li * 4 * 128 * 128; const float* sgb = (const float*)KIN(I_SGUB) + (size_t)li * 4 * 128;
                    char* V_lds = (char*)lds + RING_OFF;
                    int tid2 = threadIdx.x; asm volatile("" : "+v"(tid2)); const int lane2 = tid2 & 63;
                    const int r32 = lane2 & 31, hi2 = lane2 >> 5, sr = tid2 >> 4, sc = (tid2 & 15) * 8;
                    for (int s = vcu; s < 4 * 64 * 4; s += G) { const int g = s & 3, n = (s >> 2) & 63, b = s >> 8;
                        const size_t row0 = (size_t)b * SEQ + n * 128;
                        const int tb = (wave & 3) * 32, ch = wave >> 2;
                        bf16x8 vst[4];
#pragma unroll
                        for (int p = 0; p < 4; ++p) vst[p] = att::ld8(Zb + (row0 + 32 * p + sr) * ZP + 5120 + g * 128 + sc);
                        const bf16* wrow = sgw + ((size_t)g * 128 + tb + r32) * 128 + 8 * hi2;
                        bf16x8 wa[8];
#pragma unroll
                        for (int i = 0; i < 8; ++i) wa[i] = att::ld8(wrow + 16 * i);
                        const size_t rowt = row0 + tb + r32;
                        const bf16* up = Zb + rowt * ZP + 4608 + g * 128 + ch * 64 + 4 * hi2;
                        u32x2 uv[2][4];
#pragma unroll
                        for (int e = 0; e < 2; ++e)
#pragma unroll
                            for (int rg = 0; rg < 4; ++rg) uv[e][rg] = *(const u32x2*)(up + e * 32 + 8 * rg);
                        const float bias = sgb[g * 128 + tb + r32];
#pragma unroll
                        for (int p = 0; p < 4; ++p) { const int k = 32 * p + sr; *(bf16x8*)(V_lds + (k >> 6) * att::SHM_V + att::v_st(k & 63, sc)) = vst[p]; }
                        __syncthreads();
                        f32x16 o0 = {}, o1 = {};
                        const int vb0 = (int)(uintptr_t)V_lds + att::v_rd_base(lane2) + ch * 1024;
                        { bf16x8 pa0 = wa[0], pa1 = wa[1], pa2 = wa[2], pa3 = wa[3];
                          PVT_D0(0, 0, o0); PVT_D0(0, 1, o1); }
                        if (tb >= 64) { bf16x8 pa0 = wa[4], pa1 = wa[5], pa2 = wa[6], pa3 = wa[7];
                          PVT_D0(1, 0, o0); PVT_D0(1, 1, o1); }
                        bf16* op = AO + rowt * DM + AW + g * 128 + ch * 64 + 4 * hi2;
#pragma unroll
                        for (int e = 0; e < 2; ++e)
#pragma unroll
                            for (int rg = 0; rg < 4; ++rg) { const u32x2 u2 = uv[e][rg]; float m4[4];
#pragma unroll
                                for (int j = 0; j < 4; ++j) m4[j] = (e ? o1[4 * rg + j] : o0[4 * rg + j]) + bias;
                                u32x2 w; w.x = cvt_pk_bf16(bf_lo(u2.x) * m4[0], bf_hi(u2.x) * m4[1]); w.y = cvt_pk_bf16(bf_lo(u2.y) * m4[2], bf_hi(u2.y) * m4[3]);
                                *(u32x2*)(op + e * 32 + 8 * rg) = w; }
                        __syncthreads();
                    }
                }
            } else {
                const bf16* GBp = Zb; const bf16* Yp = Zb + (size_t)MTOK * DM; const float* cw = (const float*)KIN(I_CW) + (size_t)li * 3 * DM;
                const int r0 = gw * 16; const bool first = (r0 % SEQ) == 0;
                for (int cc = 0; cc < 4; ++cc) { const int col = 512 * cc + 8 * lane;
                    float w0[8], w1[8], w2[8], ym2[8], ym1[8];
#pragma unroll
                    for (int j = 0; j < 8; ++j) { w0[j] = cw[col + j]; w1[j] = cw[DM + col + j]; w2[j] = cw[2 * DM + col + j]; ym2[j] = 0.f; ym1[j] = 0.f; }
                    if (!first) { const u32x4 a = *(const u32x4*)(Yp + (size_t)(r0 - 2) * DM + col), c = *(const u32x4*)(Yp + (size_t)(r0 - 1) * DM + col);
#pragma unroll
                        for (int q = 0; q < 4; ++q) { ym2[2 * q] = bf_lo(a[q]); ym2[2 * q + 1] = bf_hi(a[q]); ym1[2 * q] = bf_lo(c[q]); ym1[2 * q + 1] = bf_hi(c[q]); } }
                    for (int rb = 0; rb < 16; rb += 8) {
                      u32x4 yq[8], gq[8];
#pragma unroll
                      for (int r = 0; r < 8; ++r) { const size_t off = (size_t)(r0 + rb + r) * DM + col; yq[r] = *(const u32x4*)(Yp + off); gq[r] = *(const u32x4*)(GBp + off); }
#pragma unroll
                      for (int r = 0; r < 8; ++r) { const size_t off = (size_t)(r0 + rb + r) * DM + col;
                        const u32x4 yv = yq[r], gv = gq[r];
                        float y0[8], gb[8], o[8];
#pragma unroll
                        for (int q = 0; q < 4; ++q) { y0[2 * q] = bf_lo(yv[q]); y0[2 * q + 1] = bf_hi(yv[q]); gb[2 * q] = bf_lo(gv[q]); gb[2 * q + 1] = bf_hi(gv[q]); }
#pragma unroll
                        for (int j = 0; j < 8; ++j) { o[j] = gb[j] * (w0[j] * ym2[j] + w1[j] * ym1[j] + w2[j] * y0[j]); ym2[j] = ym1[j]; ym1[j] = y0[j]; }
                        u32x4 w; w.x = pk2(o[0], o[1]); w.y = pk2(o[2], o[3]); w.z = pk2(o[4], o[5]); w.w = pk2(o[6], o[7]);
                        *(u32x4*)(AO + off) = w; } }
                }
            }
        }
        SEAM(pb + 2);
        if (even_layer) {
            if (IN(pb + 3)) { PH_SETUP(); bf16* AO = (bf16*)(ws + WS_AO); const bf16* OB = (const bf16*)(ws + WS_OB); const float* LSE = (const float*)(ws + WS_LSE);
                for (int rb = 0; rb < 16; rb += 2) {
                  float lq[2][3][3]; u32x4 oq[2][3][3];
#pragma unroll
                  for (int rr = 0; rr < 2; ++rr) { const size_t row = (size_t)gw * 16 + rb + rr;
#pragma unroll
                      for (int j = 0; j < 3; ++j) { const int c = lane + 64 * j, h = c >> 4;
#pragma unroll
                          for (int b3 = 0; b3 < 3; ++b3) { lq[rr][j][b3] = LSE[(size_t)b3 * MTOK * NAH + row * NAH + h]; oq[rr][j][b3] = *(const u32x4*)(OB + (size_t)b3 * MTOK * AW + row * AW + 8 * c); } } }
#pragma unroll
                  for (int rr = 0; rr < 2; ++rr) { const size_t row = (size_t)gw * 16 + rb + rr;
#pragma unroll
                    for (int j = 0; j < 3; ++j) { const int c = lane + 64 * j;
                        const float l0 = lq[rr][j][0], l1 = lq[rr][j][1], l2 = lq[rr][j][2];
                        const float mx = fmaxf(l0, fmaxf(l1, l2)); float e0 = fast_exp(l0 - mx), e1 = fast_exp(l1 - mx), e2 = fast_exp(l2 - mx);
                        const float inv = 1.0f / (e0 + e1 + e2); e0 *= inv; e1 *= inv; e2 *= inv;
                        const u32x4 a = oq[rr][j][0], bq = oq[rr][j][1], cq = oq[rr][j][2];
                        u32x4 w;
#pragma unroll
                        for (int q = 0; q < 4; ++q) w[q] = pk2(e0 * bf_lo(a[q]) + e1 * bf_lo(bq[q]) + e2 * bf_lo(cq[q]), e0 * bf_hi(a[q]) + e1 * bf_hi(bq[q]) + e2 * bf_hi(cq[q]));
                        *(u32x4*)(AO + row * DM + 8 * c) = w; } } }
            }
            SEAM(pb + 3);
        }
        if (IN(pb + 4)) { PH_SETUP(); const bf16* AO = (const bf16*)(ws + WS_AO); bf16* xb = (bf16*)(ws + WS_XB); bf16* xw = args.dry ? (bf16*)(ws + WS_OB) : xb;
            const bf16* wo = even_layer ? (const bf16*)(ws + WS_WOUTE + li * SZ_WSQ) : (const bf16*)(ws + WS_WOUTO + li * SZ_WSQ);
            pg8::Gemm g{AO, wo, MTOK, DM, DM}; pg8::StaticOrder S; S.init(MTOK, DM, G, bx);
            pg8::EpiRes E{xb, xw, mv + 2 * DM, 6 * DM, (bf16*)(ws + WS_H), mv + 3 * DM, 6 * DM, (u64*)(ws + WS_SSQ) + (size_t)(2 * layer) * MTOK, ldsl + LDSCTL_OFF + 1024};
            pg8::gemm_phase<pg8::EpiRes, pg8::StaticOrder, true, true>(ldsl + RING_OFF, g, S, E, tid);
        }
        SEAM(pb + 4);
        if (IN(pb + 6)) { PH_SETUP(); const bf16* Hb = (const bf16*)(ws + WS_H); bf16* Zb = (bf16*)(ws + WS_Z);
            pg8::Gemm g{Hb, (const bf16*)(ws + WS_WGU + layer * SZ_WGU), MTOK, NGU, DM}; pg8::StaticOrder S; S.init(MTOK, NGU, G, bx);
            pg8::EpiGU E{Zb, NormIn{(const u64*)(ws + WS_SSQ) + (size_t)(2 * layer) * MTOK, (const i64*)(ws + WS_BIASR) + BIAS_GU + (size_t)layer * 4 * NGU, NGU, ldsl + LDSCTL_OFF + 1024}};
            pg8::gemm_phase<pg8::EpiGU, pg8::StaticOrder, true, true>(ldsl + RING_OFF, g, S, E, tid);
        }
        SEAM(pb + 6);
        if (IN(pb + 7)) { PH_SETUP(); const bf16* Zb = (const bf16*)(ws + WS_Z); bf16* xb = (bf16*)(ws + WS_XB); bf16* xw = args.dry ? (bf16*)(ws + WS_OB) : xb;
            pg8::Gemm g{Zb, (const bf16*)(ws + WS_WD + layer * SZ_WD), MTOK, DM, DFF}; pg8::StaticOrder S; S.init(MTOK, DM, G, bx);
            pg8::EpiRes E{xb, xw, mv + 5 * DM, 6 * DM, layer < 3 ? (bf16*)(ws + WS_H) : (bf16*)nullptr, mv + 4 * 6 * DM, 6 * DM, (u64*)(ws + WS_SSQ) + (size_t)(2 * layer + 1) * MTOK, ldsl + LDSCTL_OFF + 1024};
            pg8::gemm_phase<pg8::EpiRes, pg8::StaticOrder, true, true>(ldsl + RING_OFF, g, S, E, tid);
        }
        SEAM(pb + 7);
    }
    if (IN(35)) { OPAQUE_TID(); unsigned char* ws = KWS(); final_rows(gw, lane, (const bf16*)(ws + WS_XB), KOUT(), (const float*)KIN(I_FNORM), (const u64*)(ws + WS_SSQ) + (size_t)7 * MTOK); }
#undef IN
#undef SEAM
}

extern "C" void kernel_launch(void* const* d_in, const int* in_sizes, int n_in, void* d_out, int out_size, void* d_ws, size_t ws_size, hipStream_t stream) {
    static int grid = 0;
    if (grid == 0) {
        if (n_in != 18 || out_size != MTOK * DM || ws_size < WS_END) { fprintf(stderr, "kernel_launch: unexpected shapes (n_in %d, out %d, ws %zu; need ws >= %zu)\n", n_in, out_size, ws_size, (size_t)WS_END); grid = -1; return; }
        int dev = 0, cus = 0, per_cu = 0;
        if (hipGetDevice(&dev) != hipSuccess || hipDeviceGetAttribute(&cus, hipDeviceAttributeMultiprocessorCount, dev) != hipSuccess) { grid = -1; return; }
        if (hipFuncSetAttribute((const void*)mega_fwd, hipFuncAttributeMaxDynamicSharedMemorySize, LDS_BYTES) != hipSuccess) { fprintf(stderr, "kernel_launch: hipFuncSetAttribute failed\n"); grid = -1; return; }
        if (hipOccupancyMaxActiveBlocksPerMultiprocessor(&per_cu, (const void*)mega_fwd, NWAVES * 64, LDS_BYTES) != hipSuccess || per_cu < 1)
            fprintf(stderr, "kernel_launch: note: occupancy query reports %d workgroups per CU\n", per_cu);
        (void)hipGetLastError();
        grid = cus;
        if (grid != 256) fprintf(stderr, "kernel_launch: %d CUs (built for 256)\n", grid);
    }
    if (grid < 0) return;
    (void)in_sizes;
    if (hipMemsetAsync((char*)d_ws + WS_CTL, 0, CTL_ZERO_BYTES, stream) != hipSuccess) return;
    Args a{};
    for (int i = 0; i < 18; ++i) a.in[i] = d_in[i];
    a.out = (float*)d_out; a.ws = (unsigned char*)d_ws;
#if MK_PER_PHASE
    for (int p = 0; p < 36; ++p) { if (p >= 3 && p < 35) { const int k = (p - 3) % 8, l = (p - 3) / 8; if (k == 0 || k == 5 || (k == 3 && (l & 1))) continue; }
        a.ph_lo = p; a.ph_hi = p + 1; hipLaunchKernelGGL(mega_fwd, dim3(grid), dim3(NWAVES * 64), LDS_BYTES, stream, a); }
#else
    a.ph_lo = 0; a.ph_hi = 36;
    hipLaunchKernelGGL(mega_fwd, dim3(grid), dim3(NWAVES * 64), LDS_BYTES, stream, a);
    for (int r = 0; r < PROBE_REPS; ++r) { (void)hipMemsetAsync((char*)d_ws + WS_CTL, 0, CTL_ZERO_BYTES, stream);
        a.ph_lo = PROBE_LO; a.ph_hi = PROBE_HI; a.dry = PROBE_DRY; hipLaunchKernelGGL(mega_fwd, dim3(grid), dim3(NWAVES * 64), LDS_BYTES, stream, a); }
#endif
}
```
